# Optimizing an MI355X kernel written in HIP

```python
import jax, jax.numpy as jnp
from jax import lax
import numpy as np

D_MODEL = 4096
BATCH = 8
SEQ = 2048
DEPTH = 2

CHUNK = 64
N_MIXERS = 2
HEAD_DIM = 128
N_HEADS = D_MODEL // HEAD_DIM
A_KV_HEADS = N_HEADS // 4
A_GROUP = N_HEADS // A_KV_HEADS
IDX_HEADS = N_HEADS
IDX_DIM = 128
TOPK_MAX = 256
SPARSE_Q_BLOCK = 32
A_Q = N_HEADS * HEAD_DIM
A_KV = A_KV_HEADS * HEAD_DIM
A_IQ = IDX_HEADS * IDX_DIM
A_IN = A_Q + 2 * A_KV + A_IQ + IDX_DIM + IDX_HEADS
LEFT_CHUNKS = 8
BAND = (LEFT_CHUNKS + 1) * CHUNK
REL_CLIP = 256
B_HID = N_HEADS * HEAD_DIM
B_IN = 3 * B_HID
MEM_TOKENS = 256
MEM_HEADS = 4
MEM_HEAD_DIM = 128
MEM_DIM = MEM_HEADS * MEM_HEAD_DIM
D_FF = 4 * D_MODEL
ROPE_THETA = 10000.0
EPS = 1e-6
N_A_LAYERS = (DEPTH + N_MIXERS - 1) // N_MIXERS
N_B_LAYERS = DEPTH // N_MIXERS

kernel_name = "hybrid_dsa_chunkband_memory_trunk"


def rmsnorm(x, g):
    x32 = x.astype(jnp.float32)
    y = x32 * lax.rsqrt(jnp.mean(x32 * x32, axis=-1, keepdims=True) + EPS)
    return (y * g.astype(jnp.float32)).astype(x.dtype)


def rope(x, pos):
    half = x.shape[-1] // 2
    inv = ROPE_THETA ** (-jnp.arange(half, dtype=jnp.float32) / half)
    ang = pos.astype(jnp.float32)[:, None] * inv[None, :]
    cos = jnp.cos(ang)[:, None, :]
    sin = jnp.sin(ang)[:, None, :]
    x32 = x.astype(jnp.float32)
    x1, x2 = x32[..., :half], x32[..., half:]
    return jnp.concatenate([x1 * cos - x2 * sin, x2 * cos + x1 * sin], axis=-1).astype(x.dtype)


def dsa_sparse_attention(h, w_in, w_out):
    bsz, seq, _ = h.shape
    proj = h @ w_in
    cuts = np.cumsum([A_Q, A_KV, A_KV, A_IQ, IDX_DIM]).tolist()
    q, k, v, qi, ki, wi = jnp.split(proj, cuts, axis=-1)
    pos = jnp.arange(seq)
    q = rope(q.reshape(bsz, seq, N_HEADS, HEAD_DIM), pos)
    k = rope(k.reshape(bsz, seq, A_KV_HEADS, HEAD_DIM), pos)
    v = v.reshape(bsz, seq, A_KV_HEADS, HEAD_DIM)
    qi = rope(qi.reshape(bsz, seq, IDX_HEADS, IDX_DIM), pos)
    ki = rope(ki[:, :, None, :], pos)[:, :, 0, :]
    wi = wi * (IDX_HEADS ** -0.5)
    top_k = min(TOPK_MAX, seq // 4)
    key_chunk = pos // CHUNK
    n_blocks = seq // SPARSE_Q_BLOCK
    gather = jax.vmap(lambda t, i: t[i])

    def block(i):
        t0 = i * SPARSE_Q_BLOCK
        q_b = lax.dynamic_slice_in_dim(q, t0, SPARSE_Q_BLOCK, axis=1)
        qi_b = lax.dynamic_slice_in_dim(qi, t0, SPARSE_Q_BLOCK, axis=1)
        wi_b = lax.dynamic_slice_in_dim(wi, t0, SPARSE_Q_BLOCK, axis=1)
        q_chunk = (t0 + jnp.arange(SPARSE_Q_BLOCK)) // CHUNK
        admissible = key_chunk[None, :] <= q_chunk[:, None]
        dots = jnp.einsum('bthd,bsd->bths', qi_b, ki).astype(jnp.float32) * (IDX_DIM ** -0.5)
        score = jnp.einsum('bth,bths->bts', wi_b.astype(jnp.float32), jax.nn.relu(dots))
        score = jnp.where(admissible[None], score, -jnp.inf)
        _, idx = lax.top_k(score, top_k)
        valid = key_chunk[idx] <= q_chunk[None, :, None]
        k_sel = gather(k, idx)
        v_sel = gather(v, idx)
        q_g = q_b.reshape(bsz, SPARSE_Q_BLOCK, A_KV_HEADS, A_GROUP, HEAD_DIM)
        logits = jnp.einsum('btkgd,btnkd->btkgn', q_g, k_sel).astype(jnp.float32) * (HEAD_DIM ** -0.5)
        logits = jnp.where(valid[:, :, None, None, :], logits, -jnp.inf)
        p = jax.nn.softmax(logits, axis=-1).astype(v.dtype)
        o = jnp.einsum('btkgn,btnkd->btkgd', p, v_sel)
        return o.reshape(bsz, SPARSE_Q_BLOCK, A_Q)

    out = lax.map(block, jnp.arange(n_blocks))
    out = jnp.moveaxis(out, 0, 1).reshape(bsz, seq, A_Q)
    return out @ w_out


def chunk_band_attention(h, w_in, rel_bias, w_out):
    bsz, seq, _ = h.shape
    q, k, v = jnp.split(h @ w_in, 3, axis=-1)
    q = q.reshape(bsz, seq, N_HEADS, HEAD_DIM)
    k = k.reshape(bsz, seq, N_HEADS, HEAD_DIM)
    v = v.reshape(bsz, seq, N_HEADS, HEAD_DIM)
    pad = LEFT_CHUNKS * CHUNK
    k_pad = jnp.pad(k, ((0, 0), (pad, 0), (0, 0), (0, 0)))
    v_pad = jnp.pad(v, ((0, 0), (pad, 0), (0, 0), (0, 0)))
    t_loc = jnp.arange(CHUNK)
    j_loc = jnp.arange(BAND)
    rel = t_loc[:, None] + pad - j_loc[None, :]
    rel_idx = jnp.clip(rel, -REL_CLIP, REL_CLIP) + REL_CLIP
    bias = rel_bias[:, rel_idx].astype(jnp.float32)
    n_chunks = seq // CHUNK

    def chunk(c):
        q_c = lax.dynamic_slice_in_dim(q, c * CHUNK, CHUNK, axis=1)
        k_c = lax.dynamic_slice_in_dim(k_pad, c * CHUNK, BAND, axis=1)
        v_c = lax.dynamic_slice_in_dim(v_pad, c * CHUNK, BAND, axis=1)
        valid = (c * CHUNK - pad + j_loc) >= 0
        logits = jnp.einsum('bthd,bshd->bhts', q_c, k_c).astype(jnp.float32) * (HEAD_DIM ** -0.5)
        logits = jnp.where(valid[None, None, None, :], logits + bias[None], -jnp.inf)
        p = jax.nn.softmax(logits, axis=-1).astype(v.dtype)
        o = jnp.einsum('bhts,bshd->bthd', p, v_c)
        return o.reshape(bsz, CHUNK, B_HID)

    out = lax.map(chunk, jnp.arange(n_chunks))
    out = jnp.moveaxis(out, 0, 1).reshape(bsz, seq, B_HID)
    return out @ w_out


def memory_cross_attention(h, mem_n, w_q, w_k, w_v, w_o):
    bsz, seq, _ = h.shape
    q = (h @ w_q).reshape(bsz, seq, MEM_HEADS, MEM_HEAD_DIM)
    k = (mem_n @ w_k).reshape(bsz, -1, MEM_HEADS, MEM_HEAD_DIM)
    v = (mem_n @ w_v).reshape(bsz, -1, MEM_HEADS, MEM_HEAD_DIM)
    logits = jnp.einsum('bshd,bmhd->bhsm', q, k).astype(jnp.float32) * (MEM_HEAD_DIM ** -0.5)
    p = jax.nn.softmax(logits, axis=-1).astype(v.dtype)
    o = jnp.einsum('bhsm,bmhd->bshd', p, v).reshape(bsz, seq, MEM_DIM)
    return o @ w_o


def squared_relu_mlp(h, w_up, w_down):
    a = jax.nn.relu(h @ w_up)
    return (a * a) @ w_down


def setup_inputs(seed: int = 0) -> dict:
    key = jax.random.key(seed)
    ks = jax.random.split(key, 20)
    f32 = jnp.float32

    def w(k, shape, fan_in):
        return jax.random.normal(k, shape, f32) * (fan_in ** -0.5)

    def gain(k, shape):
        return 1.0 + 0.02 * jax.random.normal(k, shape, f32)

    return {
        "x": jax.random.normal(ks[0], (BATCH, SEQ, D_MODEL), f32),
        "mem": jax.random.normal(ks[1], (BATCH, MEM_TOKENS, D_MODEL), f32),
        "g_mix": gain(ks[2], (DEPTH, D_MODEL)),
        "g_mem_attn": gain(ks[3], (DEPTH, D_MODEL)),
        "g_ffn": gain(ks[4], (DEPTH, D_MODEL)),
        "g_memory": gain(ks[5], (D_MODEL,)),
        "g_final": gain(ks[6], (D_MODEL,)),
        "w_in_a": w(ks[7], (N_A_LAYERS, D_MODEL, A_IN), D_MODEL),
        "w_out_a": w(ks[8], (N_A_LAYERS, A_Q, D_MODEL), A_Q),
        "w_in_b": w(ks[9], (N_B_LAYERS, D_MODEL, B_IN), D_MODEL),
        "rel_bias": 0.1 * jax.random.normal(ks[10], (N_B_LAYERS, N_HEADS, 2 * REL_CLIP + 1), f32),
        "w_out_b": w(ks[11], (N_B_LAYERS, B_HID, D_MODEL), B_HID),
        "w_mq": w(ks[12], (DEPTH, D_MODEL, MEM_DIM), D_MODEL),
        "w_mk": w(ks[13], (DEPTH, D_MODEL, MEM_DIM), D_MODEL),
        "w_mv": w(ks[14], (DEPTH, D_MODEL, MEM_DIM), D_MODEL),
        "w_mo": w(ks[15], (DEPTH, MEM_DIM, D_MODEL), MEM_DIM),
        "w_up": w(ks[16], (DEPTH, D_MODEL, D_FF), D_MODEL),
        "w_down": w(ks[17], (DEPTH, D_FF, D_MODEL), D_FF),
    }


def reference(x, mem, g_mix, g_mem_attn, g_ffn, g_memory, g_final, w_in_a, w_out_a,
              w_in_b, rel_bias, w_out_b, w_mq, w_mk, w_mv, w_mo, w_up, w_down):
    mem_n = rmsnorm(mem, g_memory)
    for i in range(DEPTH):
        h = rmsnorm(x, g_mix[i])
        j = i // N_MIXERS
        if i % N_MIXERS == 0:
            x = x + dsa_sparse_attention(h, w_in_a[j], w_out_a[j])
        else:
            x = x + chunk_band_attention(h, w_in_b[j], rel_bias[j], w_out_b[j])
        x = x + memory_cross_attention(rmsnorm(x, g_mem_attn[i]), mem_n,
                                       w_mq[i], w_mk[i], w_mv[i], w_mo[i])
        x = x + squared_relu_mlp(rmsnorm(x, g_ffn[i]), w_up[i], w_down[i])
    return rmsnorm(x, g_final)
```

```cpp
#include <hip/hip_runtime.h>
#include <cstdio>
#include <cstdint>

#define LAS __attribute__((address_space(3)))
typedef unsigned short bf16_t;
typedef short bf16x8 __attribute__((ext_vector_type(8)));
typedef short s16x4 __attribute__((ext_vector_type(4)));
typedef float f32x4 __attribute__((ext_vector_type(4)));
typedef float f32x16 __attribute__((ext_vector_type(16)));
typedef unsigned u32x4 __attribute__((ext_vector_type(4)));
typedef unsigned u32x2 __attribute__((ext_vector_type(2)));
typedef int v4i_t __attribute__((ext_vector_type(4)));
typedef int v8i_t __attribute__((ext_vector_type(8)));

#ifndef PROBE_MASK
#define PROBE_MASK 0
#endif
#define DUP(k, ...) do { { constexpr int dup_ = 0; (void)dup_; __VA_ARGS__ } if constexpr (((PROBE_MASK >> (k)) & 1) != 0) { constexpr int dup_ = 1; (void)dup_; __VA_ARGS__ } } while (0);
constexpr int BATCH = 8, SEQ = 2048, DM = 4096, MTOK = BATCH * SEQ;
constexpr int A_IN = 10400, A_IN_PAD = 10496;
constexpr int B_IN = 12288, DFF = 16384, MEMT = 256, MEMD = 512;
constexpr float EPS = 1e-6f;

constexpr size_t MiB = 1u << 20;
constexpr size_t WS_CTL = 0, CTL_ZERO_BYTES = 1 * MiB;
constexpr size_t WS_COS = 1 * MiB, WS_SIN = WS_COS + 512 * 1024;
constexpr size_t WS_WA_IN = 2 * MiB;
constexpr size_t WS_WA_OUT = 84 * MiB;
constexpr size_t WS_WB_IN = 116 * MiB;
constexpr size_t WS_WB_OUT = 212 * MiB;
constexpr size_t WS_WMQ = 244 * MiB;
constexpr size_t WS_WMKV = 252 * MiB;
constexpr size_t WS_WMO = 268 * MiB;
constexpr size_t WS_WUP = 276 * MiB;
constexpr size_t WS_WDN = 532 * MiB;
constexpr size_t WS_HN = 788 * MiB;
constexpr size_t WS_MEMN = 916 * MiB;
constexpr size_t WS_MKV = 932 * MiB;
constexpr size_t WS_MQ = 940 * MiB;
constexpr size_t WS_MASK = 956 * MiB;
constexpr size_t WS_KI = 960 * MiB;
constexpr size_t WS_WI = 964 * MiB;
constexpr size_t WS_BIG = 968 * MiB;
constexpr size_t WS_Q = WS_BIG;
constexpr size_t WS_K0 = WS_BIG + 128 * MiB;
constexpr size_t WS_V0 = WS_BIG + 160 * MiB;
constexpr size_t WS_QI = WS_BIG + 192 * MiB;
constexpr size_t WS_SC = WS_BIG + 320 * MiB;
constexpr size_t WS_K1 = WS_BIG + 128 * MiB;
constexpr size_t WS_V1 = WS_BIG + 256 * MiB;
constexpr size_t WS_A1 = WS_BIG;
constexpr size_t WS_O = WS_BIG + 512 * MiB;
constexpr size_t WS_MO = WS_O + 128 * MiB;
constexpr size_t WS_X8 = WS_MO + 16 * MiB;
constexpr size_t WS_WA_IN8 = WS_X8 + 64 * MiB;
constexpr size_t WS_END = WS_WA_IN8 + 24 * MiB;
constexpr size_t WS_CS = 960 * 1024;
constexpr float C_A = 4.5f;
constexpr size_t WS_QS = 1000 * 1024;
constexpr float KQ = 4.25f, QINV = 127.0f / KQ, QMUL = KQ / 127.0f;
constexpr size_t X8_DELTA = WS_X8 - WS_HN;
constexpr int CW_BAR = 4096;
constexpr size_t WS_SS = 64 * 1024;
#define SSP(i) ((unsigned long long*)(ws + WS_SS + (size_t)(i) * 131072))
#define SSD WSP(unsigned long long, WS_MASK)
__device__ __forceinline__ unsigned long long ss_fix(float s) { return (unsigned long long)(long long)(s * 16777216.0f); }
__device__ __forceinline__ float ss_mean(unsigned long long v) { return ((float)(unsigned)(v >> 32) * 4294967296.0f + (float)(unsigned)v) * (1.0f / (16777216.0f * 4096.0f)) + EPS; }
__device__ __forceinline__ float ss_rms(unsigned long long v) { return __builtin_amdgcn_sqrtf(ss_mean(v)); }
__device__ __forceinline__ float ss_rstd(unsigned long long v) { return __builtin_amdgcn_rsqf(ss_mean(v)); }

constexpr int LDS_BYTES = 147456;
constexpr int MISC_OFF = LDS_BYTES - 64;

__device__ __forceinline__ unsigned cvt_pk_bf16(float lo, float hi) { unsigned r; asm volatile("v_cvt_pk_bf16_f32 %0, %1, %2" : "=v"(r) : "v"(lo), "v"(hi)); return r; }
__device__ __forceinline__ unsigned cvt_pk_fp8(float a, float b, float c, float d) { unsigned w = 0; w = __builtin_amdgcn_cvt_pk_fp8_f32(a, b, w, false); w = __builtin_amdgcn_cvt_pk_fp8_f32(c, d, w, true); return w; }
__device__ __forceinline__ unsigned pk_i8(float a, float b, float c, float d) {
    const int ia = __float2int_rn(fminf(fmaxf(a, -127.f), 127.f)), ib = __float2int_rn(fminf(fmaxf(b, -127.f), 127.f)), ic = __float2int_rn(fminf(fmaxf(c, -127.f), 127.f)), id = __float2int_rn(fminf(fmaxf(d, -127.f), 127.f));
    return ((unsigned)ia & 255u) | (((unsigned)ib & 255u) << 8) | (((unsigned)ic & 255u) << 16) | ((unsigned)id << 24);
}
__device__ __forceinline__ float wave_sum(float v) {
    v += __builtin_bit_cast(float, __builtin_amdgcn_update_dpp(0, __builtin_bit_cast(int, v), 0xB1, 0xF, 0xF, true));
    v += __builtin_bit_cast(float, __builtin_amdgcn_update_dpp(0, __builtin_bit_cast(int, v), 0x4E, 0xF, 0xF, true));
    v += __builtin_bit_cast(float, __builtin_amdgcn_update_dpp(0, __builtin_bit_cast(int, v), 0x141, 0xF, 0xF, true));
    v += __builtin_bit_cast(float, __builtin_amdgcn_update_dpp(0, __builtin_bit_cast(int, v), 0x140, 0xF, 0xF, true));
    const int iv = __builtin_bit_cast(int, v);
    return (__builtin_bit_cast(float, __builtin_amdgcn_readlane(iv, 0)) + __builtin_bit_cast(float, __builtin_amdgcn_readlane(iv, 16))) +
           (__builtin_bit_cast(float, __builtin_amdgcn_readlane(iv, 32)) + __builtin_bit_cast(float, __builtin_amdgcn_readlane(iv, 48)));
}
__device__ __forceinline__ int wave_isum(int v) {
    v += __builtin_amdgcn_update_dpp(0, v, 0xB1, 0xF, 0xF, true);
    v += __builtin_amdgcn_update_dpp(0, v, 0x4E, 0xF, 0xF, true);
    v += __builtin_amdgcn_update_dpp(0, v, 0x141, 0xF, 0xF, true);
    v += __builtin_amdgcn_update_dpp(0, v, 0x140, 0xF, 0xF, true);
    return (__builtin_amdgcn_readlane(v, 0) + __builtin_amdgcn_readlane(v, 16)) + (__builtin_amdgcn_readlane(v, 32) + __builtin_amdgcn_readlane(v, 48));
}
#define PIN8(r) asm volatile("" : "+v"((r)[0]), "+v"((r)[1]), "+v"((r)[2]), "+v"((r)[3]), "+v"((r)[4]), "+v"((r)[5]), "+v"((r)[6]), "+v"((r)[7]) :: "memory")
#define LDS_WAIT() asm volatile("s_waitcnt lgkmcnt(0)" ::: "memory")
#define VM_WAIT() asm volatile("s_waitcnt vmcnt(0)" ::: "memory")

#define XB_TMO      128
#define XB_XCNT(j)  (256  + 64 * (j))
#define XB_XSUB(j)  (1280 + 64 * (j))
#define XB_XGEN(j)  (2304 + 64 * (j))
#define XB_TOP      3328
#define XB_TOPGEN   3392
#define XCD_BAR_WORDS 3456
#define XB_SPIN_CAP (1u << 18)
__device__ __forceinline__ unsigned xb_ld(unsigned* p)              { return __hip_atomic_load(p, __ATOMIC_RELAXED, __HIP_MEMORY_SCOPE_AGENT); }
__device__ __forceinline__ unsigned xb_add(unsigned* p, unsigned v) { return __hip_atomic_fetch_add(p, v, __ATOMIC_RELAXED, __HIP_MEMORY_SCOPE_AGENT); }
__device__ __forceinline__ unsigned xb_xcc_id() { return (unsigned)__builtin_amdgcn_s_getreg((3 << 11) | 20) & 0xFu; }
#define XB_SPIN(cond, bar) do { unsigned _sp = 0; while (cond) { __builtin_amdgcn_s_sleep(1); \
    if ((++_sp & 255u) == 0u) { if (xb_ld(&(bar)[XB_TMO])) break; if (_sp > XB_SPIN_CAP) { atomicAdd(&(bar)[XB_TMO], 1u); break; } } } } while (0)
struct XcdBarrier { unsigned* bar; unsigned x; volatile LAS unsigned* st; bool lead; };
__device__ __forceinline__ int hw_lane() { int l; asm volatile("v_mbcnt_lo_u32_b32 %0, -1, 0\n\tv_mbcnt_hi_u32_b32 %0, -1, %0" : "=v"(l)); return l; }
__device__ __forceinline__ XcdBarrier xcd_barrier_post(unsigned* bar, volatile LAS unsigned* st) {
    XcdBarrier b; b.bar = bar; b.x = xb_xcc_id(); b.st = st; b.lead = threadIdx.x == 0;
    if (threadIdx.x == 0) (void)xb_add(&bar[XB_XCNT(b.x)], 1u);
    return b;
}
__device__ __forceinline__ void xcd_barrier_complete(unsigned* bar, unsigned x, unsigned& nloc, unsigned& nx) {
    const unsigned G = gridDim.x * gridDim.y * gridDim.z;
    unsigned sum, cnt, mine, sp = 0u;
    for (;;) {
        sum = 0u; cnt = 0u; mine = 0u;
#pragma unroll
        for (unsigned j = 0; j < 16; ++j) { const unsigned c = xb_ld(&bar[XB_XCNT(j)]); sum += c; cnt += (c > 0u) ? 1u : 0u; mine = (j == x) ? c : mine; }
        if (sum == G) break;
        __builtin_amdgcn_s_sleep(1);
        if ((++sp & 255u) == 0u) { if (xb_ld(&bar[XB_TMO])) break; if (sp > XB_SPIN_CAP) { atomicAdd(&bar[XB_TMO], 1u); break; } }
    }
    nloc = mine > 0u ? mine : 1u; nx = cnt > 0u ? cnt : 1u;
}
__device__ __forceinline__ void xcd_barrier(const XcdBarrier& b) {
    asm volatile("s_waitcnt vmcnt(0)" ::: "memory");
    __syncthreads();
    if (b.lead) {
        unsigned* bar = b.bar;
        __builtin_amdgcn_s_waitcnt(0);
        unsigned nloc = b.st[0], nx = b.st[1];
        if (nloc == 0u) { xcd_barrier_complete(bar, b.x, nloc, nx); b.st[0] = nloc; b.st[1] = nx; }
        const unsigned old = xb_add(&bar[XB_XSUB(b.x)], 1u);
        const unsigned gen = old / nloc;
        if (old + 1u == (gen + 1u) * nloc) {
            __builtin_amdgcn_fence(__ATOMIC_RELEASE, "agent");
            asm volatile("s_waitcnt vmcnt(0)" ::: "memory");
            const unsigned og = xb_add(&bar[XB_TOP], 1u);
            const unsigned tg = og / nx;
            if (og + 1u == (tg + 1u) * nx) xb_add(&bar[XB_TOPGEN], 1u);
            else XB_SPIN(xb_ld(&bar[XB_TOPGEN]) == tg, bar);
            __builtin_amdgcn_fence(__ATOMIC_ACQUIRE, "agent");
            xb_add(&bar[XB_XGEN(b.x)], 1u);
            asm volatile("s_waitcnt vmcnt(0)" ::: "memory");
        } else {
            XB_SPIN(xb_ld(&bar[XB_XGEN(b.x)]) == gen, bar);
            __builtin_amdgcn_fence(__ATOMIC_ACQUIRE, "agent");
            asm volatile("s_waitcnt vmcnt(0)" ::: "memory");
        }
    }
    __syncthreads();
}

namespace pg8 {
constexpr int BM = 256, BK = 64, HALF = 128, HTB = HALF * BK * 2, STAGE_BYTES = 8 * HTB, NXCD = 8, WGM = 4, WGM_UP = 8, WGM_DN = 4;
__host__ __device__ __forceinline__ int lds_byte(int r, int c) { const int st = (r >> 4) * 2 + (c >> 5), rr = r & 15, cc = c & 31, ob = rr * 64 + cc * 2; return st * 1024 + (ob ^ (((ob >> 9) & 1) << 5)); }
__host__ __device__ __forceinline__ void stage_rc(int b, int& R, int& C) { const int st = b / 1024, sb = b % 1024, swz = sb ^ (((sb >> 9) & 1) << 5); R = (st >> 1) * 16 + swz / 64; C = (st & 1) * 32 + (swz % 64) / 2; }
__host__ __device__ __forceinline__ int perm32(int rho) { const int n = rho >> 4, i = rho & 15; return 8 * (i >> 2) + 4 * n + (i & 3); }
struct Unit { int pm, pn; };
struct Gemm { const bf16_t* A; const bf16_t* Bt; int M, N, K, ld; };
struct StaticOrder {
    int nM, nN, nwg, G, c, wgm;
    __host__ __device__ void init(int M, int N, int G_, int c_, int wgm_ = WGM) { nM = M / BM; nN = N / BM; nwg = nM * nN; G = G_; c = c_; wgm = wgm_; }
    __host__ __device__ bool next(int i, Unit& u) const {
        const long L = (long)i * G + c; if (L >= nwg) return false;
        int wgid = (int)L; { const int q = nwg / NXCD, r = nwg % NXCD, xcd = wgid % NXCD, off = wgid / NXCD; wgid = (xcd < r ? xcd * (q + 1) : r * (q + 1) + (xcd - r) * q) + off; }
        const int nig = wgm * nN, gid = wgid / nig, fm = gid * wgm, gsz = (nM - fm) < wgm ? (nM - fm) : wgm;
        u.pm = fm + ((wgid % nig) % gsz); u.pn = (wgid % nig) / gsz; return true;
    }
    __device__ __forceinline__ void a_ready(const Unit&) const {}
    __device__ __forceinline__ void done(const Unit&) const {}
};

template <int ACT  , bool SPLIT8 = false  > struct EpiBf16 {
    static constexpr bool PERM = true, AFTER_DRAIN = false;
    bf16_t* O; int ldc; int split_cols; size_t split_stride; const unsigned long long* SS; float osc; unsigned char* O8; const unsigned long long* SSq;
    __device__ __forceinline__ void operator()(const f32x4 (&acc)[2][2][4][2], const Unit& u, int wr, int wc, int fr, int fq) const {
        const int row0 = u.pm * BM + wr * 64 + fr; int colt = u.pn * BM; bf16_t* base = O;
        if (split_cols) { const int t = colt / split_cols; base += (size_t)t * split_stride; colt -= t * split_cols; }
        const int col0 = colt + wc * 32 + 8 * fq;
        float rsv[8];
#pragma unroll
        for (int r = 0; r < 8; ++r) { const int row = row0 + (r >> 2) * HALF + (r & 3) * 16; float v = osc; if (SS) v *= ss_rstd(SS[row]); if (SSq) v *= ss_rms(SSq[row]); rsv[r] = v; }
        PIN8(rsv);
#pragma unroll
        for (int ai = 0; ai < 2; ++ai)
#pragma unroll
            for (int m = 0; m < 4; ++m) { bf16_t* rowp = base + (size_t)(row0 + ai * HALF + m * 16) * ldc + col0;
                const float rs = rsv[ai * 4 + m];
#pragma unroll
                for (int bj = 0; bj < 2; ++bj) { f32x4 v0 = acc[ai][bj][m][0] * rs, v1 = acc[ai][bj][m][1] * rs;
                    if (ACT == 1) {
#pragma unroll
                        for (int j = 0; j < 4; ++j) { const float a = fmaxf(v0[j], 0.f), b = fmaxf(v1[j], 0.f); v0[j] = a * a; v1[j] = b * b; } }
                    u32x4 w; w.x = cvt_pk_bf16(v0[0], v0[1]); w.y = cvt_pk_bf16(v0[2], v0[3]); w.z = cvt_pk_bf16(v1[0], v1[1]); w.w = cvt_pk_bf16(v1[2], v1[3]);
                    if (SPLIT8 && u.pn >= 32) { u32x2 q; q.x = cvt_pk_fp8(v0[0] * 2.f, v0[1] * 2.f, v0[2] * 2.f, v0[3] * 2.f); q.y = cvt_pk_fp8(v1[0] * 2.f, v1[1] * 2.f, v1[2] * 2.f, v1[3] * 2.f);
                        __builtin_nontemporal_store(q, (u32x2*)(O8 + (size_t)(row0 + ai * HALF + m * 16) * 8192 + (u.pn - 32) * BM + wc * 32 + 8 * fq + bj * HALF)); }
                    else if (ACT == 1) __builtin_nontemporal_store(w, (u32x4*)(rowp + bj * HALF));
                    else *(u32x4*)(rowp + bj * HALF) = w; } }
    }
};
struct EpiHidI8 {
    static constexpr bool PERM = true, AFTER_DRAIN = false;
    unsigned char* O; int ldc; const unsigned long long* SS; float osc; const unsigned long long* SSq; float ainv;
    __device__ __forceinline__ void operator()(const f32x4 (&acc)[2][2][4][2], const Unit& u, int wr, int wc, int fr, int fq) const {
        const int row0 = u.pm * BM + wr * 64 + fr, col0 = u.pn * BM + wc * 32 + 8 * fq;
        float rsv[8];
#pragma unroll
        for (int r = 0; r < 8; ++r) { const int row = row0 + (r >> 2) * HALF + (r & 3) * 16; rsv[r] = ss_rstd(SS[row]) * osc * ss_rms(SSq[row]); }
        PIN8(rsv);
#pragma unroll
        for (int ai = 0; ai < 2; ++ai)
#pragma unroll
            for (int m = 0; m < 4; ++m) { const int row = row0 + ai * HALF + m * 16; unsigned char* rowp = O + (size_t)row * ldc + col0;
                const float rs = rsv[ai * 4 + m];
#pragma unroll
                for (int bj = 0; bj < 2; ++bj) { unsigned w[2];
#pragma unroll
                    for (int n = 0; n < 2; ++n) { unsigned q[4];
#pragma unroll
                        for (int j = 0; j < 4; ++j) { const float a = acc[ai][bj][m][n][j] * rs;
                            q[j] = __float_as_uint(__builtin_amdgcn_fmed3f(__builtin_fmaf(a, __builtin_fabsf(a), 8388608.f), 8388608.f, 8388608.f + 255.f)); }
                        w[n] = (__builtin_amdgcn_perm(q[1], q[0], 0x0c0c0400u) | __builtin_amdgcn_perm(q[3], q[2], 0x04000c0cu)) ^ 0x80808080u; }
                    u32x2 ww; ww.x = w[0]; ww.y = w[1]; *(u32x2*)(rowp + bj * HALF) = ww; } }
    }
};
template <bool BASE_F32, int QM = 0, bool NOSS = false, bool CSUM = false> struct EpiResB;
template <bool BASE_F32, int QM  , bool NOSS  , bool CSUM  > struct EpiResB {
    static constexpr bool PERM = true, AFTER_DRAIN = false;
    const float* basef; bf16_t* X; unsigned long long* SS; float osc; const unsigned long long* SSq; const int* CS; LAS float* red;
    __device__ __forceinline__ void operator()(const f32x4 (&acc)[2][2][4][2], const Unit& u, int wr, int wc, int fr, int fq) const {
        const int row0 = u.pm * BM + wr * 64 + fr, col0 = u.pn * BM + wc * 32 + 8 * fq;
        f32x4 cs0[2], cs1[2];
        if constexpr (CSUM) {
#pragma unroll
            for (int bj = 0; bj < 2; ++bj) { const v4i_t c0 = *(const v4i_t*)(CS + col0 + bj * HALF), c1 = *(const v4i_t*)(CS + col0 + bj * HALF + 4);
                cs0[bj] = (f32x4){128.f * (float)c0[0], 128.f * (float)c0[1], 128.f * (float)c0[2], 128.f * (float)c0[3]}; cs1[bj] = (f32x4){128.f * (float)c1[0], 128.f * (float)c1[1], 128.f * (float)c1[2], 128.f * (float)c1[3]}; } }
        float qiv[8];
        if constexpr (QM == 2) {
#pragma unroll
            for (int r = 0; r < 8; ++r) qiv[r] = QINV * ss_rstd(SSq[row0 + (r >> 2) * HALF + (r & 3) * 16]);
            PIN8(qiv); }
#pragma unroll
        for (int ai = 0; ai < 2; ++ai) {
            u32x4 bw[4][2]; f32x4 bf[BASE_F32 ? 4 : 1][2][2];
#pragma unroll
            for (int m = 0; m < 4; ++m)
#pragma unroll
                for (int bj = 0; bj < 2; ++bj) { const size_t o = (size_t)(row0 + ai * HALF + m * 16) * 4096 + col0 + bj * HALF;
                    if constexpr (BASE_F32) { bf[m][bj][0] = *(const f32x4*)(basef + o); bf[m][bj][1] = *(const f32x4*)(basef + o + 4); }
                    else bw[m][bj] = *(const u32x4*)(X + o); }
            if constexpr (BASE_F32) { asm volatile("" ::: "memory"); }
            else {
#pragma unroll
                for (int m = 0; m < 4; ++m) asm volatile("" : "+v"(bw[m][0]), "+v"(bw[m][1]) :: "memory"); }
#pragma unroll
            for (int m = 0; m < 4; ++m) { const int row = row0 + ai * HALF + m * 16; const size_t ro = (size_t)row * 4096 + col0; float ss = 0.f;
                float qi = 0.f; if constexpr (QM == 2) qi = qiv[ai * 4 + m];
#pragma unroll
                for (int bj = 0; bj < 2; ++bj) { const size_t o = ro + bj * HALF; f32x4 b0, b1;
                    if constexpr (BASE_F32) { b0 = bf[m][bj][0]; b1 = bf[m][bj][1]; }
                    else { const u32x4 w = bw[m][bj];
                        b0 = (f32x4){__uint_as_float(w.x << 16), __uint_as_float(w.x & 0xffff0000u), __uint_as_float(w.y << 16), __uint_as_float(w.y & 0xffff0000u)};
                        b1 = (f32x4){__uint_as_float(w.z << 16), __uint_as_float(w.z & 0xffff0000u), __uint_as_float(w.w << 16), __uint_as_float(w.w & 0xffff0000u)}; }
                    f32x4 a0 = acc[ai][bj][m][0], a1 = acc[ai][bj][m][1]; if constexpr (CSUM) { a0 = a0 + cs0[bj]; a1 = a1 + cs1[bj]; }
                    const f32x4 v0 = b0 + a0 * osc, v1 = b1 + a1 * osc;
                    ss += ((v0[0] * v0[0] + v0[1] * v0[1]) + (v0[2] * v0[2] + v0[3] * v0[3])) + ((v1[0] * v1[0] + v1[1] * v1[1]) + (v1[2] * v1[2] + v1[3] * v1[3]));
                    u32x4 w; w.x = cvt_pk_bf16(v0[0], v0[1]); w.y = cvt_pk_bf16(v0[2], v0[3]); w.z = cvt_pk_bf16(v1[0], v1[1]); w.w = cvt_pk_bf16(v1[2], v1[3]);
                    *(u32x4*)(X + o) = w;
                    if constexpr (QM == 1) { u32x2 q; q.x = cvt_pk_fp8(v0[0], v0[1], v0[2], v0[3]); q.y = cvt_pk_fp8(v1[0], v1[1], v1[2], v1[3]); *(u32x2*)((unsigned char*)X + X8_DELTA + o) = q; }
                    if constexpr (QM == 2) { u32x2 q; q.x = pk_i8(v0[0] * qi, v0[1] * qi, v0[2] * qi, v0[3] * qi); q.y = pk_i8(v1[0] * qi, v1[1] * qi, v1[2] * qi, v1[3] * qi); *(u32x2*)((unsigned char*)X + X8_DELTA + o) = q; } }
                { auto r16 = __builtin_amdgcn_permlane16_swap(__float_as_uint(ss), __float_as_uint(ss), false, false); ss = __uint_as_float(r16[0]) + __uint_as_float(r16[1]);
                  auto r32_ = __builtin_amdgcn_permlane32_swap(__float_as_uint(ss), __float_as_uint(ss), false, false); ss = __uint_as_float(r32_[0]) + __uint_as_float(r32_[1]); }
                if (!NOSS && fq == 0) red[wc * 256 + wr * 64 + fr + ai * HALF + m * 16] = ss; } }
        if constexpr (!NOSS) {
            LDS_WAIT(); __builtin_amdgcn_s_barrier();
            if (wr == 0) { const int rt = wc * 64 + fq * 16 + fr; const float t = (red[rt] + red[256 + rt]) + (red[512 + rt] + red[768 + rt]); atomicAdd(SS + u.pm * BM + rt, ss_fix(t)); } }
    }
};
struct EpiInA {
    static constexpr bool PERM = true, AFTER_DRAIN = false;
    bf16_t *Q, *Kb, *Vb, *QI, *KI; float* WI; const float* COS; const float* SIN; const unsigned long long* SS; int seg0; float osc;
    __device__ __forceinline__ void operator()(const f32x4 (&acc)[2][2][4][2], const Unit& u, int wr, int wc, int fr, int fq) const {
        const int row0 = u.pm * BM + wr * 64 + fr;
        const int g = wc * 4 + fq;
        float rr[8];
#pragma unroll
        for (int r = 0; r < 8; ++r) rr[r] = SS ? ss_rstd(SS[row0 + (r >> 2) * HALF + (r & 3) * 16]) : 1.0f;
        PIN8(rr);
        const int segA = seg0 + u.pn * 2;
        const bool rope0 = !(segA >= 40 && segA < 48) && segA < 81, rope1 = !(segA + 1 >= 40 && segA + 1 < 48) && segA + 1 < 81;
#pragma unroll
        for (int ah = 0; ah < 4; ++ah) { const int ai = ah >> 1, mh = (ah & 1) * 2;
            f32x4 cv[2], sv[2];
            if (rope0 || rope1) {
#pragma unroll
                for (int m = 0; m < 2; ++m) { const int pos = (row0 + ai * HALF + (mh + m) * 16) & (SEQ - 1); cv[m] = *(const f32x4*)(COS + pos * 64 + g * 4); sv[m] = *(const f32x4*)(SIN + pos * 64 + g * 4); }
#pragma unroll
                for (int m = 0; m < 2; ++m) asm volatile("" : "+v"(cv[m]), "+v"(sv[m]) :: "memory"); }
#pragma unroll
            for (int bj = 0; bj < 2; ++bj) {
                const int seg = segA + bj;
                bf16_t* dst; int ld; int mode;
                if (seg < 32)       { dst = Q  + seg * 128;        ld = 4096; mode = 0; }
                else if (seg < 40)  { dst = Kb + (seg - 32) * 128; ld = 1024; mode = 0; }
                else if (seg < 48)  { dst = Vb + (seg - 40) * 128; ld = 1024; mode = 1; }
                else if (seg < 80)  { dst = QI + (seg - 48) * 128; ld = 4096; mode = 0; }
                else if (seg == 80) { dst = KI;                    ld = 128;  mode = 0; }
                else                { dst = nullptr;               ld = 0;    mode = 2; }
                if (mode == 2) {
                    if (wc == 0) {
#pragma unroll
                        for (int m2 = 0; m2 < 2; ++m2) { const int m = mh + m2; float* p = WI + (size_t)(row0 + ai * HALF + m * 16) * 32 + fq * 8;
                            const float rs = 0.015625f * rr[ai * 4 + m];
                            *(f32x4*)p = acc[ai][bj][m][0] * rs; *(f32x4*)(p + 4) = acc[ai][bj][m][1] * rs; }
                    }
                } else {
#pragma unroll
                    for (int m2 = 0; m2 < 2; ++m2) { const int m = mh + m2; const int row = row0 + ai * HALF + m * 16;
                        const float rs = rr[ai * 4 + m] * osc;
                        f32x4 v0 = acc[ai][bj][m][0] * rs, v1 = acc[ai][bj][m][1] * rs;
                        if (mode == 0) { const f32x4 c4 = cv[m2], s4 = sv[m2];
                            const f32x4 y1 = v0 * c4 - v1 * s4, y2 = v1 * c4 + v0 * s4; v0 = y1; v1 = y2; }
                        u32x4 w; w.x = cvt_pk_bf16(v0[0], v0[1]); w.y = cvt_pk_bf16(v0[2], v0[3]); w.z = cvt_pk_bf16(v1[0], v1[1]); w.w = cvt_pk_bf16(v1[2], v1[3]);
                        *(u32x4*)(dst + (size_t)row * ld + g * 8) = w; }
                }
            }
        }
    }
};

__device__ __forceinline__ void mma8_f8(f32x4 (&a)[4][2], const v8i_t (&bt)[2], const v8i_t (&at)[4], unsigned sc) {
    asm volatile("v_mfma_scale_f32_16x16x128_f8f6f4 %0, %8, %10, %0, %14, %14 op_sel_hi:[0,0,0]\n\t"
                 "v_mfma_scale_f32_16x16x128_f8f6f4 %1, %9, %10, %1, %14, %14 op_sel_hi:[0,0,0]\n\t"
                 "v_mfma_scale_f32_16x16x128_f8f6f4 %2, %8, %11, %2, %14, %14 op_sel_hi:[0,0,0]\n\t"
                 "v_mfma_scale_f32_16x16x128_f8f6f4 %3, %9, %11, %3, %14, %14 op_sel_hi:[0,0,0]\n\t"
                 "v_mfma_scale_f32_16x16x128_f8f6f4 %4, %8, %12, %4, %14, %14 op_sel_hi:[0,0,0]\n\t"
                 "v_mfma_scale_f32_16x16x128_f8f6f4 %5, %9, %12, %5, %14, %14 op_sel_hi:[0,0,0]\n\t"
                 "v_mfma_scale_f32_16x16x128_f8f6f4 %6, %8, %13, %6, %14, %14 op_sel_hi:[0,0,0]\n\t"
                 "v_mfma_scale_f32_16x16x128_f8f6f4 %7, %9, %13, %7, %14, %14 op_sel_hi:[0,0,0]"
                 : "+v"(a[0][0]), "+v"(a[0][1]), "+v"(a[1][0]), "+v"(a[1][1]), "+v"(a[2][0]), "+v"(a[2][1]), "+v"(a[3][0]), "+v"(a[3][1])
                 : "v"(bt[0]), "v"(bt[1]), "v"(at[0]), "v"(at[1]), "v"(at[2]), "v"(at[3]), "v"(sc));
}
template <class Epi, class Sched, bool ALIGN_EPI = false, bool SP2 = false, int PREC = 0>
__device__ __forceinline__ void gemm_phase(LAS unsigned char* lds, const Gemm g, const Sched& S, const Epi& E, const int tid) {
    const int wid = __builtin_amdgcn_readfirstlane(tid >> 6), lane = tid & 63, wr = wid >> 2, wc = wid & 3, fr = lane & 15, fq = lane >> 4;
    constexpr bool F8 = (PREC == 1), I8 = (PREC == 2);
    const int K = g.K, LDE = g.ld ? g.ld : K, RB = PREC ? LDE : 2 * LDE  , nt = (PREC ? K : 2 * K) / 128;
    unsigned voffA[2], voffB[2];
#pragma unroll
    for (int i = 0; i < 2; ++i) { int R, C; stage_rc(tid * 16 + i * 8192, R, C); const int Rb = Epi::PERM ? ((R & ~31) + perm32(R & 31)) : R;
        voffA[i] = (unsigned)(R * RB + 2 * C); voffB[i] = (unsigned)(Rb * RB + 2 * C); }
    const size_t kstep = (size_t)(BK * 2);
    const size_t hstep = (size_t)HALF * RB;
    const size_t tstep = 2 * hstep;
    const unsigned ldsw = (unsigned)wid * 1024u;
    const int aoff = F8 ? lds_byte(wr * 64 + fr, fq * 16) : lds_byte(wr * 64 + fr, fq * 8), boff = F8 ? lds_byte(wc * 32 + fr, fq * 16) : lds_byte(wc * 32 + fr, fq * 8);
    constexpr int KOFF = F8 ? 16 : 1024;
#define PG8_SA(b, h) (((b) * 2 + (h)) * HTB)
#define PG8_SB(b, h) ((4 + (b) * 2 + (h)) * HTB)
#define PG8_STAGE(bufoff, gbase, voff) do { _Pragma("unroll") for (int _i = 0; _i < 2; ++_i) \
        __builtin_amdgcn_global_load_lds((const unsigned*)((const char*)(gbase) + (voff)[_i]), (LAS unsigned*)(lds + (bufoff) + ldsw + _i * 8192), 16, 0, 0); } while (0)
#define PG8_LDA(dst, b, h) do { _Pragma("unroll") for (int m = 0; m < 4; ++m) _Pragma("unroll") for (int k = 0; k < 2; ++k) dst[m][k] = *(const LAS bf16x8*)(lds + PG8_SA(b, h) + aoff + m * 2048 + k * KOFF); } while (0)
#define PG8_LDB(dst, b, h) do { _Pragma("unroll") for (int n = 0; n < 2; ++n) _Pragma("unroll") for (int k = 0; k < 2; ++k) dst[n][k] = *(const LAS bf16x8*)(lds + PG8_SB(b, h) + boff + n * 2048 + k * KOFF); } while (0)
#define PG8_CAT(x) __builtin_shufflevector(__builtin_bit_cast(v4i_t, (x)[0]), __builtin_bit_cast(v4i_t, (x)[1]), 0, 1, 2, 3, 4, 5, 6, 7)
#define PG8_MMA(ai, bj, At, Bt) do { __builtin_amdgcn_s_setprio(1); _Pragma("unroll") for (int m = 0; m < 4; ++m) _Pragma("unroll") for (int n = 0; n < 2; ++n) { \
        if constexpr (PREC == 0) { _Pragma("unroll") for (int k = 0; k < 2; ++k) acc[ai][bj][m][n] = __builtin_amdgcn_mfma_f32_16x16x32_bf16(Bt[n][k], At[m][k], acc[ai][bj][m][n], 0, 0, 0); } \
        if constexpr (I8) { _Pragma("unroll") for (int k = 0; k < 2; ++k) acc[ai][bj][m][n] = __builtin_bit_cast(f32x4, __builtin_amdgcn_mfma_i32_16x16x64_i8(__builtin_bit_cast(v4i_t, Bt[n][k]), __builtin_bit_cast(v4i_t, At[m][k]), __builtin_bit_cast(v4i_t, acc[ai][bj][m][n]), 0, 0, 0)); } } \
        if constexpr (F8) { const v8i_t bt_[2] = {PG8_CAT(Bt[0]), PG8_CAT(Bt[1])}; const v8i_t at_[4] = {PG8_CAT(At[0]), PG8_CAT(At[1]), PG8_CAT(At[2]), PG8_CAT(At[3])}; mma8_f8(acc[ai][bj], bt_, at_, f8scale); } \
        __builtin_amdgcn_s_setprio(0); } while (0)
#define PG8_WAIT_V(n) asm volatile("s_waitcnt vmcnt(" #n ")" ::: "memory")
#define PG8_WAIT_L(n) asm volatile("s_waitcnt lgkmcnt(" #n ")" ::: "memory")
#define PG8_BAR __builtin_amdgcn_s_barrier()
#define PG8_SCHED __builtin_amdgcn_sched_barrier(0)
    Unit cur, nxt; int ui = 0;
    if (!S.next(0, cur)) return;
    f32x4 acc[2][2][4][2];
#pragma unroll
    for (int a = 0; a < 2; ++a)
#pragma unroll
        for (int b = 0; b < 2; ++b)
#pragma unroll
            for (int m = 0; m < 4; ++m)
#pragma unroll
                for (int n = 0; n < 2; ++n) acc[a][b][m][n] = (f32x4){0.f, 0.f, 0.f, 0.f};
    bf16x8 At[4][2], B0[2][2], B1[2][2];
    unsigned f8scale = 0x7F7F7F7Fu; asm volatile("" : "+v"(f8scale));
    const char* cA = (const char*)g.A + (size_t)cur.pm * tstep; const char* cB = (const char*)g.Bt + (size_t)cur.pn * tstep;
    S.a_ready(cur);
    if constexpr (SP2) {
        PG8_STAGE(PG8_SB(0, 0), cB, voffB); PG8_STAGE(PG8_SB(0, 1), cB + hstep, voffB); PG8_STAGE(PG8_SA(0, 0), cA, voffA); PG8_STAGE(PG8_SA(0, 1), cA + hstep, voffA);
        if (wr == 1) PG8_BAR;
        PG8_WAIT_V(2); PG8_BAR;
        PG8_STAGE(PG8_SB(1, 0), cB + kstep, voffB); PG8_STAGE(PG8_SA(1, 0), cA + kstep, voffA); PG8_STAGE(PG8_SB(1, 1), cB + hstep + kstep, voffB);
        PG8_WAIT_V(6); PG8_BAR;
    } else {
        PG8_STAGE(PG8_SB(0, 0), cB, voffB); PG8_STAGE(PG8_SA(0, 0), cA, voffA); PG8_STAGE(PG8_SB(0, 1), cB + hstep, voffB); PG8_STAGE(PG8_SA(0, 1), cA + hstep, voffA);
        if (wr == 1) PG8_BAR;
        PG8_WAIT_V(4); PG8_BAR;
        PG8_STAGE(PG8_SB(1, 0), cB + kstep, voffB); PG8_STAGE(PG8_SA(1, 0), cA + kstep, voffA); PG8_STAGE(PG8_SB(1, 1), cB + hstep + kstep, voffB);
        PG8_WAIT_V(6); PG8_BAR;
    }
    for (;;) {
        const bool has_next = S.next(ui + 1, nxt);
        const char* nA = has_next ? (const char*)g.A + (size_t)nxt.pm * tstep : cA; const char* nB = has_next ? (const char*)g.Bt + (size_t)nxt.pn * tstep : cB;
        for (int t = 0; t < nt; t += 2) {
            const bool last = (t == nt - 2);
            const char* a1 = cA + (size_t)(t + 1) * kstep;
            const char* a2 = last ? nA : cA + (size_t)(t + 2) * kstep; const char* b2 = last ? nB : cB + (size_t)(t + 2) * kstep;
            const char* a3 = a2 + kstep; const char* b3 = b2 + kstep;
            if (last && has_next) S.a_ready(nxt);
            if constexpr (SP2) {
            PG8_LDB(B0, 0, 0); PG8_LDB(B1, 0, 1); PG8_SCHED; PG8_LDA(At, 0, 0); PG8_STAGE(PG8_SA(1, 1), a1 + hstep, voffA);
            PG8_WAIT_V(8); PG8_WAIT_L(0); PG8_BAR; PG8_MMA(0, 0, At, B0); PG8_MMA(0, 1, At, B1); PG8_BAR; PG8_SCHED;
            PG8_LDA(At, 0, 1); PG8_STAGE(PG8_SB(0, 0), b2, voffB); PG8_STAGE(PG8_SB(0, 1), b2 + hstep, voffB); PG8_STAGE(PG8_SA(0, 0), a2, voffA);
            PG8_WAIT_V(8); PG8_WAIT_L(0); PG8_BAR; PG8_MMA(1, 0, At, B0); PG8_MMA(1, 1, At, B1); PG8_BAR; PG8_SCHED;
            PG8_LDB(B0, 1, 0); PG8_LDB(B1, 1, 1); PG8_SCHED; PG8_LDA(At, 1, 0); PG8_STAGE(PG8_SA(0, 1), a2 + hstep, voffA);
            PG8_WAIT_V(8); PG8_WAIT_L(0); PG8_BAR; PG8_MMA(0, 0, At, B0); PG8_MMA(0, 1, At, B1); PG8_BAR; PG8_SCHED;
            PG8_LDA(At, 1, 1); PG8_STAGE(PG8_SB(1, 0), b3, voffB); PG8_STAGE(PG8_SB(1, 1), b3 + hstep, voffB); PG8_STAGE(PG8_SA(1, 0), a3, voffA);
            PG8_WAIT_V(8); PG8_WAIT_L(0); PG8_BAR; PG8_MMA(1, 0, At, B0); PG8_MMA(1, 1, At, B1); PG8_BAR; PG8_SCHED;
            } else {
            PG8_LDB(B0, 0, 0); PG8_SCHED; PG8_LDA(At, 0, 0); PG8_STAGE(PG8_SA(1, 1), a1 + hstep, voffA);
            PG8_WAIT_L(8); PG8_BAR; PG8_WAIT_L(0); PG8_MMA(0, 0, At, B0); PG8_BAR; PG8_SCHED;
            PG8_LDB(B1, 0, 1); PG8_STAGE(PG8_SB(0, 0), b2, voffB);
            PG8_BAR; PG8_WAIT_L(0); PG8_MMA(0, 1, At, B1); PG8_BAR;
            PG8_LDA(At, 0, 1); PG8_STAGE(PG8_SA(0, 0), a2, voffA);
            PG8_BAR; PG8_WAIT_L(0); PG8_MMA(1, 0, At, B0); PG8_BAR; PG8_SCHED;
            PG8_STAGE(PG8_SB(0, 1), b2 + hstep, voffB);
            PG8_WAIT_V(6); PG8_BAR; PG8_MMA(1, 1, At, B1); PG8_BAR;
            PG8_LDB(B0, 1, 0); PG8_SCHED; PG8_LDA(At, 1, 0); PG8_STAGE(PG8_SA(0, 1), a2 + hstep, voffA);
            PG8_WAIT_L(8); PG8_BAR; PG8_WAIT_L(0); PG8_MMA(0, 0, At, B0); PG8_BAR; PG8_SCHED;
            PG8_LDB(B1, 1, 1); PG8_STAGE(PG8_SB(1, 0), b3, voffB);
            PG8_BAR; PG8_WAIT_L(0); PG8_MMA(0, 1, At, B1); PG8_BAR;
            PG8_LDA(At, 1, 1); PG8_STAGE(PG8_SA(1, 0), a3, voffA);
            PG8_BAR; PG8_WAIT_L(0); PG8_MMA(1, 0, At, B0); PG8_BAR; PG8_SCHED;
            PG8_STAGE(PG8_SB(1, 1), b3 + hstep, voffB);
            PG8_WAIT_V(6); PG8_BAR; PG8_MMA(1, 1, At, B1); PG8_BAR;
            }
        }
        if constexpr (ALIGN_EPI) { if (wr == 0) PG8_BAR; }
        if constexpr (F8) asm volatile("s_nop 15\n\ts_nop 15" ::: "memory");
        if constexpr (I8) {
#pragma unroll
            for (int a = 0; a < 2; ++a)
#pragma unroll
                for (int b = 0; b < 2; ++b)
#pragma unroll
                    for (int m = 0; m < 4; ++m)
#pragma unroll
                        for (int n = 0; n < 2; ++n) { const v4i_t iv = __builtin_bit_cast(v4i_t, acc[a][b][m][n]); acc[a][b][m][n] = (f32x4){(float)iv[0], (float)iv[1], (float)iv[2], (float)iv[3]}; } }
        if constexpr (!Epi::AFTER_DRAIN) { E(acc, cur, wr, wc, fr, fq); S.done(cur); }
        if (!has_next) break;
#pragma unroll
        for (int a = 0; a < 2; ++a)
#pragma unroll
            for (int b = 0; b < 2; ++b)
#pragma unroll
                for (int m = 0; m < 4; ++m)
#pragma unroll
                    for (int n = 0; n < 2; ++n) acc[a][b][m][n] = (f32x4){0.f, 0.f, 0.f, 0.f};
        cur = nxt; cA = nA; cB = nB; ++ui;
        if constexpr (ALIGN_EPI) { if (wr == 1) PG8_BAR; }
    }
    PG8_WAIT_V(0);
    if constexpr (!ALIGN_EPI) { if (wr == 0) PG8_BAR; }
    PG8_BAR;
#undef PG8_SA
#undef PG8_SB
#undef PG8_STAGE
#undef PG8_LDA
#undef PG8_LDB
#undef PG8_MMA
#undef PG8_CAT
#undef PG8_WAIT_V
#undef PG8_WAIT_L
#undef PG8_BAR
#undef PG8_SCHED
}
}

namespace att {
constexpr int D = 128, NW = 8, QBLK = 32, KVBLK = 64;
constexpr float SCALE = 0.088388347648318440f;
constexpr float THR = 8.f;
constexpr int SHM_V = KVBLK * D * 2, SHM_K = KVBLK * D * 2;
constexpr int OFF_WS = 2 * SHM_V + 2 * SHM_K;
constexpr int OFF_BT = OFF_WS + NW * 64 * 4;
constexpr int OFF_Q = OFF_BT + 4096;
constexpr int SHM_ATTN = OFF_Q + NW * 8704;
static_assert(SHM_ATTN <= MISC_OFF, "attention LDS map");
#define KSWZ(row, colB) ((row) * 256 + ((colB) ^ (((row) & 7) << 4)))
#define SBAR() __builtin_amdgcn_sched_barrier(0)
#define MBIT(r) (((r) & 3) + 8 * ((r) >> 2))
__device__ __forceinline__ int crow(int r, int hi) { return (r & 3) + 8 * (r >> 2) + 4 * hi; }
__device__ __forceinline__ unsigned cvtpk(float lo, float hi) { unsigned r; asm volatile("v_cvt_pk_bf16_f32 %0, %1, %2" : "=v"(r) : "v"(lo), "v"(hi)); return r; }

template <int MODE>
__device__ __forceinline__ void partialSM(f32x16& p0, f32x16& p1, float& m_reg, float& mn, float& alpha, const LAS float* bt) {
    constexpr float C = SCALE * 1.4426950408889634f;
    float pmax = p0[0];
#pragma unroll
    for (int r = 1; r < 16; ++r) pmax = fmaxf(pmax, p0[r]);
#pragma unroll
    for (int r = 0; r < 16; ++r) pmax = fmaxf(pmax, p1[r]);
    { auto rr = __builtin_amdgcn_permlane32_swap(__float_as_uint(pmax), __float_as_uint(pmax), false, false);
      pmax = fmaxf(__uint_as_float(rr[0]), __uint_as_float(rr[1])); }
    if (__builtin_expect(__all(pmax - m_reg <= THR / SCALE), 1)) { mn = m_reg; alpha = 1.f; }
    else { mn = fmaxf(m_reg, pmax); alpha = __builtin_amdgcn_exp2f((m_reg - mn) * C); m_reg = mn; }
    const float mnC = -mn * C;
    if (MODE == 1) {
#pragma unroll
        for (int r = 0; r < 16; ++r) p0[r] = fmaf(p0[r], C, mnC) + bt[MBIT(r)];
#pragma unroll
        for (int r = 0; r < 16; ++r) p1[r] = fmaf(p1[r], C, mnC) + bt[32 + MBIT(r)];
    } else {
#pragma unroll
        for (int r = 0; r < 16; ++r) p0[r] = fmaf(p0[r], C, mnC);
#pragma unroll
        for (int r = 0; r < 16; ++r) p1[r] = fmaf(p1[r], C, mnC);
    }
#pragma unroll
    for (int r = 0; r < 16; ++r) p0[r] = __builtin_amdgcn_exp2f(p0[r]);
}
template <int MODE>
__device__ __forceinline__ void finishSM(f32x16& p0, f32x16& p1, float alpha, float& l_reg, bf16x8& pa0, bf16x8& pa1, bf16x8& pa2, bf16x8& pa3, unsigned mlo, unsigned mhi) {
#pragma unroll
    for (int r = 0; r < 16; ++r) p1[r] = __builtin_amdgcn_exp2f(p1[r]);
    if (MODE == 0) {
#pragma unroll
        for (int r = 0; r < 16; ++r) { p0[r] = __uint_as_float(__float_as_uint(p0[r]) & (unsigned)__builtin_amdgcn_sbfe((int)mlo, MBIT(r), 1));
                                       p1[r] = __uint_as_float(__float_as_uint(p1[r]) & (unsigned)__builtin_amdgcn_sbfe((int)mhi, MBIT(r), 1)); }
    }
    float ps = 0;
#pragma unroll
    for (int r = 0; r < 16; ++r) ps += p0[r];
#pragma unroll
    for (int r = 0; r < 16; ++r) ps += p1[r];
    { auto rr = __builtin_amdgcn_permlane32_swap(__float_as_uint(ps), __float_as_uint(ps), false, false);
      ps = __uint_as_float(rr[0]) + __uint_as_float(rr[1]); }
    l_reg = l_reg * alpha + ps;
#define PK4(P, BASE, OUT) do { unsigned a0 = cvtpk(P[BASE + 0], P[BASE + 1]), a1 = cvtpk(P[BASE + 2], P[BASE + 3]);   \
    unsigned b0 = cvtpk(P[BASE + 4], P[BASE + 5]), b1 = cvtpk(P[BASE + 6], P[BASE + 7]);                              \
    auto r0 = __builtin_amdgcn_permlane32_swap(a0, b0, false, false); auto r1 = __builtin_amdgcn_permlane32_swap(a1, b1, false, false); \
    u32x4 w = {r0[0], r1[0], r0[1], r1[1]}; OUT = *reinterpret_cast<bf16x8*>(&w); } while (0)
    PK4(p0, 0, pa0); PK4(p0, 8, pa1); PK4(p1, 0, pa2); PK4(p1, 8, pa3);
#undef PK4
}
__device__ __forceinline__ void qkt(f32x16& p0, f32x16& p1, const LAS char* Ks, const LAS char* qb, int r32, int hi) {
    asm volatile("" : "+v"(r32));
    p0 = f32x16{}; p1 = f32x16{};
#pragma unroll
    for (int d0 = 0; d0 < 8; ++d0) { const int cb = (d0 * 16 + hi * 8) * 2;
        const bf16x8 b0 = *reinterpret_cast<const LAS bf16x8*>(Ks + KSWZ(r32, cb));
        const bf16x8 b1 = *reinterpret_cast<const LAS bf16x8*>(Ks + KSWZ(32 + r32, cb));
        const bf16x8 q = *reinterpret_cast<const LAS bf16x8*>(qb + d0 * 32);
        p0 = __builtin_amdgcn_mfma_f32_32x32x16_bf16(b0, q, p0, 0, 0, 0);
        p1 = __builtin_amdgcn_mfma_f32_32x32x16_bf16(b1, q, p1, 0, 0, 0); }
}
__device__ __forceinline__ int v_st(int k, int c) { const int kk = (k & ~0xC) | ((k & 4) << 1) | ((k & 8) >> 1); return ((kk >> 3) * 4 + (c >> 5)) * 512 + ((kk & 7) * 32 + (c & 31)) * 2; }
__device__ __forceinline__ int v_rd_base(int lane) { return ((lane & 3) << 3) | (((lane >> 2) & 3) << 6) | (((lane >> 4) & 1) << 5) | (((lane >> 5) & 1) << 8); }
constexpr int v_rd_off(int d0, int ks, int half) { return d0 * 512 + ks * 4096 + half * 2048; }
template <int OFF> __device__ __forceinline__ s16x4 tr_read(int vb) {
    s16x4 r; asm volatile("ds_read_b64_tr_b16 %0, %1 offset:%2" : "=&v"(r) : "v"(vb), "i"(OFF) : "memory"); return r;
}
template <int D0> __device__ __forceinline__ void pv_one(f32x16& od, int vb, bf16x8 pa0, bf16x8 pa1, bf16x8 pa2, bf16x8 pa3) {
    const s16x4 l0 = tr_read<v_rd_off(D0, 0, 0)>(vb), h0 = tr_read<v_rd_off(D0, 0, 1)>(vb), l1 = tr_read<v_rd_off(D0, 1, 0)>(vb), h1 = tr_read<v_rd_off(D0, 1, 1)>(vb);
    const s16x4 l2 = tr_read<v_rd_off(D0, 2, 0)>(vb), h2 = tr_read<v_rd_off(D0, 2, 1)>(vb), l3 = tr_read<v_rd_off(D0, 3, 0)>(vb), h3 = tr_read<v_rd_off(D0, 3, 1)>(vb);
    asm volatile("s_waitcnt lgkmcnt(0)" ::: "memory"); SBAR();
#define PK(L, H) (bf16x8){L[0], L[1], L[2], L[3], H[0], H[1], H[2], H[3]}
    od = __builtin_amdgcn_mfma_f32_32x32x16_bf16(pa0, PK(l0, h0), od, 0, 0, 0);
    od = __builtin_amdgcn_mfma_f32_32x32x16_bf16(pa1, PK(l1, h1), od, 0, 0, 0);
    od = __builtin_amdgcn_mfma_f32_32x32x16_bf16(pa2, PK(l2, h2), od, 0, 0, 0);
    od = __builtin_amdgcn_mfma_f32_32x32x16_bf16(pa3, PK(l3, h3), od, 0, 0, 0);
#undef PK
}
__device__ __forceinline__ void pv_d0(f32x16* o, int vb, bf16x8 pa0, bf16x8 pa1, bf16x8 pa2, bf16x8 pa3) {
    pv_one<0>(o[0], vb, pa0, pa1, pa2, pa3); pv_one<1>(o[1], vb, pa0, pa1, pa2, pa3); pv_one<2>(o[2], vb, pa0, pa1, pa2, pa3); pv_one<3>(o[3], vb, pa0, pa1, pa2, pa3);
}

template <int MODE, int LDQ, int LDK, int LDO, bool OF8 = false>
__device__ __forceinline__ void attn_body(const bf16_t* __restrict__ Qw, const bf16_t* __restrict__ Kh, const bf16_t* __restrict__ Vh, bf16_t* __restrict__ Ow,
                                          int NT, int nvalid, const unsigned long long* __restrict__ mcol, int jlo, int jhi, int bb0, LAS char* lds, const int tid) {
    const int wid = tid >> 6, lane = tid & 63, r32 = lane & 31, hi = lane >> 5;
    LAS char* V_lds = lds; LAS char* K_lds = lds + 2 * SHM_V;
    LAS float* ws = (LAS float*)(lds + OFF_WS) + wid * 64; LAS float* li_l = ws; LAS float* al_l = ws + 32;
    const LAS float* btab = (const LAS float*)(lds + OFF_BT);
    float m_reg = -1e30f, l_reg = 0; f32x16 o[4] = {};
    LAS char* qr = lds + OFF_Q + wid * 8704 + r32 * 272 + hi * 16;
    { bf16x8 qt[8];
#pragma unroll
      for (int d0 = 0; d0 < 8; ++d0) qt[d0] = *reinterpret_cast<const bf16x8*>(Qw + d0 * 16);
#pragma unroll
      for (int d0 = 0; d0 < 8; ++d0) *reinterpret_cast<LAS bf16x8*>(qr + d0 * 32) = qt[d0]; }
    const int sr = tid >> 4, sc = (tid & 15) * 8, vst0 = v_st(sr, sc), vst1 = v_st(32 + sr, sc);
    const unsigned goff0 = (unsigned)(sr * LDK + sc);
    const int vb0 = (int)(uintptr_t)V_lds + v_rd_base(lane);
    struct { bf16x8 vs0, vs1, ks0, ks1; } sr_[1];
#define TK0(j) (((j) < nvalid ? (j) : nvalid - 1) * KVBLK)
#define SLOAD(i, j) do { const bf16_t* vp_ = Vh + (size_t)TK0(j) * LDK; const bf16_t* kp_ = Kh + (size_t)TK0(j) * LDK; \
    sr_[i].vs0 = *reinterpret_cast<const bf16x8*>(vp_ + goff0); sr_[i].vs1 = *reinterpret_cast<const bf16x8*>(vp_ + goff0 + 32u * LDK); \
    sr_[i].ks0 = *reinterpret_cast<const bf16x8*>(kp_ + goff0); sr_[i].ks1 = *reinterpret_cast<const bf16x8*>(kp_ + goff0 + 32u * LDK); } while (0)
#define SWRITE(b, i) do { *(LAS bf16x8*)(V_lds + (b) * SHM_V + vst0) = sr_[i].vs0;          \
    *(LAS bf16x8*)(V_lds + (b) * SHM_V + vst1) = sr_[i].vs1; const int kc = sc * 2;               \
    *(LAS bf16x8*)(K_lds + (b) * SHM_K + KSWZ(sr, kc)) = sr_[i].ks0;                       \
    *(LAS bf16x8*)(K_lds + (b) * SHM_K + KSWZ(32 + sr, kc)) = sr_[i].ks1; } while (0)
#define SWAIT() asm volatile("s_waitcnt vmcnt(0)" ::: "memory")
#define RESC(a) do { if (__any((a) < 1.f)) { if (hi == 0) al_l[r32] = (a); asm volatile("s_waitcnt lgkmcnt(0)" ::: "memory"); \
    _Pragma("unroll") for (int d = 0; d < 4; ++d) _Pragma("unroll") for (int r = 0; r < 16; ++r) o[d][r] *= al_l[crow(r, hi)]; } } while (0)
#define MLOAD(j, lo_, hi_) do { if (MODE == 0) { unsigned long long w_ = ((j) < nvalid) ? mcol[(j) * 2048 + r32] : 0ull; lo_ = (unsigned)w_ >> (4 * hi); hi_ = (unsigned)(w_ >> 32) >> (4 * hi); } \
    else { lo_ = 0xFFFFFFFFu; hi_ = lo_; } } while (0)
#define BT(j) (btab + (bb0 + 64 * (j)))
    f32x16 pA0, pA1, pB0, pB1; float mnA, mnB, alA = 1.f, alB = 1.f; bf16x8 pa0, pa1, pa2, pa3;
    unsigned mAlo, mAhi, mBlo, mBhi;
#define LIVE(j) (MODE != 1 || ((j) >= jlo && (j) <= jhi))
#define QK_SM(P0_, P1_, KB_, MN_, AL_, j) do { if (LIVE(j)) { qkt(P0_, P1_, KB_, qr, r32, hi); partialSM<MODE>(P0_, P1_, m_reg, MN_, AL_, BT(j)); } else AL_ = 1.f; } while (0)
    constexpr int SE = 0, SO = 0;
    SLOAD(SE, 0); asm volatile("s_waitcnt vmcnt(0)" ::: "memory"); SWRITE(0, SE); __syncthreads();
    MLOAD(0, mAlo, mAhi);
    QK_SM(pA0, pA1, K_lds, mnA, alA, 0);
    SLOAD(SO, 1);
    SWAIT(); SWRITE(1, SO); __syncthreads();
    for (int j = 1; j + 1 < NT; j += 2) {
        MLOAD(j, mBlo, mBhi);
        SBAR(); if (LIVE(j)) qkt(pB0, pB1, K_lds + SHM_K, qr, r32, hi);
        if (LIVE(j - 1)) finishSM<MODE>(pA0, pA1, alA, l_reg, pa0, pa1, pa2, pa3, mAlo, mAhi); SBAR();
        SLOAD(SO, j + 1); SBAR();
        if (LIVE(j - 1)) pv_d0(o, vb0, pa0, pa1, pa2, pa3);
        if (LIVE(j)) partialSM<MODE>(pB0, pB1, m_reg, mnB, alB, BT(j)); else alB = 1.f;
        __syncthreads(); SWAIT(); SWRITE(0, SE);
        RESC(alB); __syncthreads();
        MLOAD(j + 1, mAlo, mAhi);
        SBAR(); if (LIVE(j + 1)) qkt(pA0, pA1, K_lds, qr, r32, hi);
        if (LIVE(j)) finishSM<MODE>(pB0, pB1, alB, l_reg, pa0, pa1, pa2, pa3, mBlo, mBhi); SBAR();
        SLOAD(SE, j + 2); SBAR();
        if (LIVE(j)) pv_d0(o, vb0 + SHM_V, pa0, pa1, pa2, pa3);
        if (LIVE(j + 1)) partialSM<MODE>(pA0, pA1, m_reg, mnA, alA, BT(j + 1)); else alA = 1.f;
        __syncthreads(); SWAIT(); SWRITE(1, SO);
        RESC(alA); __syncthreads();
    }
    MLOAD(NT - 1, mBlo, mBhi);
    SBAR(); if (LIVE(NT - 1)) qkt(pB0, pB1, K_lds + SHM_K, qr, r32, hi);
    if (LIVE(NT - 2)) finishSM<MODE>(pA0, pA1, alA, l_reg, pa0, pa1, pa2, pa3, mAlo, mAhi); SBAR();
    if (LIVE(NT - 2)) pv_d0(o, vb0, pa0, pa1, pa2, pa3);
    if (LIVE(NT - 1)) partialSM<MODE>(pB0, pB1, m_reg, mnB, alB, BT(NT - 1)); else alB = 1.f;
    __syncthreads(); RESC(alB);
    if (LIVE(NT - 1)) { finishSM<MODE>(pB0, pB1, alB, l_reg, pa0, pa1, pa2, pa3, mBlo, mBhi); SBAR();
        pv_d0(o, vb0 + SHM_V, pa0, pa1, pa2, pa3); }
#undef LIVE
#undef QK_SM
    asm volatile("s_waitcnt vmcnt(0)" ::: "memory");
    if (hi == 0) li_l[r32] = l_reg; asm volatile("s_waitcnt lgkmcnt(0)" ::: "memory");
    float rli[16];
#pragma unroll
    for (int r = 0; r < 16; ++r) rli[r] = __builtin_amdgcn_rcpf(li_l[crow(r, hi)]);
    int tz = tid; asm volatile("" : "+v"(tz)); const int r32z = tz & 31, hiz = (tz >> 5) & 1;
    if constexpr (OF8) {
        LAS unsigned char* st = (LAS unsigned char*)(lds + OFF_Q + wid * 8704);
#pragma unroll
        for (int r = 0; r < 16; ++r) { const int orow = crow(r, hiz); const float sc = rli[r] * 16.0f;
#pragma unroll
            for (int d0 = 0; d0 < 4; ++d0) st[orow * 144 + d0 * 32 + r32z] = (unsigned char)(__builtin_amdgcn_cvt_pk_fp8_f32(o[d0][r] * sc, 0.f, 0, false) & 0xffu); }
        asm volatile("s_waitcnt lgkmcnt(0)" ::: "memory");
        unsigned char* Ob = (unsigned char*)Ow; const int lz = tz & 63;
#pragma unroll
        for (int it = 0; it < 4; ++it) { const int ch = it * 64 + lz, row = ch >> 3, cc = ch & 7;
            const u32x4 w = *(const LAS u32x4*)(st + row * 144 + cc * 16); *(u32x4*)(Ob + (size_t)row * LDO + cc * 16) = w; }
    } else {
#pragma unroll
    for (int r = 0; r < 16; ++r) { const int orow = crow(r, hiz);
#pragma unroll
        for (int d0 = 0; d0 < 4; ++d0) Ow[orow * LDO + d0 * 32 + r32z] = (bf16_t)(cvtpk(o[d0][r] * rli[r], 0.f) & 0xffffu); }
    }
#undef TK0
#undef SLOAD
#undef SWRITE
#undef SWAIT
#undef RESC
#undef MLOAD
#undef BT
}
}

struct Args {
    const float* in[18]; float* out; unsigned char* ws;
};
struct Frame {
    LAS unsigned char* lds; int tid, lane, wave, G, bid;
    unsigned char* ws;
};

template <class RM>
__device__ __forceinline__ void cvt_tile(const float* __restrict__ W, int K, int N, bf16_t* __restrict__ WT, RM rm, LAS float* scr, int kb, int nb, int lane, const float* __restrict__ gk = nullptr) {
    const int k0 = 64 * kb, n0 = 64 * nb, n4 = (lane & 15) * 4;
    f32x4 v[16];
    const bool inb = (n0 + n4) < N;
#pragma unroll
    for (int i = 0; i < 16; ++i) { const int k = 4 * i + (lane >> 4); v[i] = inb ? *(const f32x4*)(W + (size_t)(k0 + k) * N + n0 + n4) : (f32x4){0.f, 0.f, 0.f, 0.f}; }
    if (gk) {
#pragma unroll
        for (int i = 0; i < 16; ++i) v[i] = v[i] * gk[k0 + 4 * i + (lane >> 4)]; }
#pragma unroll
    for (int i = 0; i < 16; ++i) { const int k = 4 * i + (lane >> 4); LAS float* s = scr + k * 65 + n4; s[0] = v[i][0]; s[1] = v[i][1]; s[2] = v[i][2]; s[3] = v[i][3]; }
    LDS_WAIT(); asm volatile("" ::: "memory");
    const int c = lane & 7;
#pragma unroll
    for (int j = 0; j < 8; ++j) { const int n = 8 * j + (lane >> 3); const LAS float* s = scr + (8 * c) * 65 + n;
        u32x4 o; o.x = cvt_pk_bf16(s[0 * 65], s[1 * 65]); o.y = cvt_pk_bf16(s[2 * 65], s[3 * 65]); o.z = cvt_pk_bf16(s[4 * 65], s[5 * 65]); o.w = cvt_pk_bf16(s[6 * 65], s[7 * 65]);
        if (n0 + n < N) *(u32x4*)(WT + (size_t)rm(n0 + n) * K + k0 + 8 * c) = o; }
    LDS_WAIT(); asm volatile("" ::: "memory");
}
struct RmId { int off; __device__ __forceinline__ int operator()(int n) const { return n + off; } };
struct RmInA {
    __device__ __forceinline__ int operator()(int n) const {
        const bool rope = (n < 5120) || (n >= 6144 && n < 10368);
        if (!rope) return n;
        const int d = n & 127, i = d & 63;
        return (n & ~127) + 8 * (i >> 2) + (i & 3) + 4 * (d >> 6);
    }
};
struct CvtDesc { const float* W; bf16_t* WT; const float* gk; int K, N, k0, n0, mode, off, f8, Kout, ko; float wsc; int* cs; };
__device__ __forceinline__ void cvt_load(const CvtDesc& d, f32x4 (&v)[16], int lane) {
    const int n4 = (lane & 15) * 4; const bool inb = (d.n0 + n4) < d.N;
    const float* p = d.W + (size_t)(d.k0 + (lane >> 4)) * d.N + d.n0 + n4;
#pragma unroll
    for (int i = 0; i < 16; ++i) v[i] = inb ? __builtin_nontemporal_load((const f32x4*)(p + (size_t)(4 * i) * d.N)) : (f32x4){0.f, 0.f, 0.f, 0.f};
}
__device__ __forceinline__ void cvt_store(const CvtDesc& d, const f32x4 (&v)[16], LAS float* scr, int lane) {
    const int n4 = (lane & 15) * 4;
#pragma unroll
    for (int i = 0; i < 16; ++i) { const int k = 4 * i + (lane >> 4); const float gg = d.gk ? d.gk[d.k0 + k] : 1.0f; LAS float* s = scr + k * 65 + n4; s[0] = v[i][0] * gg; s[1] = v[i][1] * gg; s[2] = v[i][2] * gg; s[3] = v[i][3] * gg; }
    LDS_WAIT(); asm volatile("" ::: "memory");
    const int c = lane & 7;
#pragma unroll
    for (int j = 0; j < 8; ++j) { const int n = d.n0 + 8 * j + (lane >> 3); const LAS float* s = scr + (8 * c) * 65 + 8 * j + (lane >> 3);
        u32x4 o; o.x = cvt_pk_bf16(s[0 * 65], s[1 * 65]); o.y = cvt_pk_bf16(s[2 * 65], s[3 * 65]); o.z = cvt_pk_bf16(s[4 * 65], s[5 * 65]); o.w = cvt_pk_bf16(s[6 * 65], s[7 * 65]);
        const int row = d.mode ? RmInA{}(n) : n + d.off;
        if (n < d.N) *(u32x4*)(d.WT + (size_t)row * d.K + d.k0 + 8 * c) = o; }
    LDS_WAIT(); asm volatile("" ::: "memory");
}
__device__ __forceinline__ void cvt_store_f8(const CvtDesc& d, const f32x4 (&v)[16], LAS float* scr, int lane) {
    const int n4 = (lane & 15) * 4;
#pragma unroll
    for (int i = 0; i < 16; ++i) { const int k = 4 * i + (lane >> 4); const float gg = (d.gk ? d.gk[d.k0 + k] : 1.0f) * d.wsc; LAS float* s = scr + k * 65 + n4; s[0] = v[i][0] * gg; s[1] = v[i][1] * gg; s[2] = v[i][2] * gg; s[3] = v[i][3] * gg; }
    LDS_WAIT(); asm volatile("" ::: "memory");
    const int c = lane & 3;
#pragma unroll
    for (int j = 0; j < 4; ++j) { const int nl = 16 * j + (lane >> 2), n = d.n0 + nl; const LAS float* s = scr + (16 * c) * 65 + nl;
        u32x4 o; o.x = cvt_pk_fp8(s[0 * 65], s[1 * 65], s[2 * 65], s[3 * 65]); o.y = cvt_pk_fp8(s[4 * 65], s[5 * 65], s[6 * 65], s[7 * 65]);
        o.z = cvt_pk_fp8(s[8 * 65], s[9 * 65], s[10 * 65], s[11 * 65]); o.w = cvt_pk_fp8(s[12 * 65], s[13 * 65], s[14 * 65], s[15 * 65]);
        const int row = d.mode ? RmInA{}(n) : n + d.off;
        if (n < d.N) *(u32x4*)((unsigned char*)d.WT + (size_t)row * d.Kout + d.ko + 16 * c) = o; }
    LDS_WAIT(); asm volatile("" ::: "memory");
}
__device__ __forceinline__ void cvt_store_i8(const CvtDesc& d, const f32x4 (&v)[16], LAS float* scr, int lane) {
    const int n4 = (lane & 15) * 4;
#pragma unroll
    for (int i = 0; i < 16; ++i) { const int k = 4 * i + (lane >> 4); const float gg = (d.gk ? d.gk[d.k0 + k] : 1.0f) * d.wsc; LAS float* s = scr + k * 65 + n4; s[0] = v[i][0] * gg; s[1] = v[i][1] * gg; s[2] = v[i][2] * gg; s[3] = v[i][3] * gg; }
    LDS_WAIT(); asm volatile("" ::: "memory");
    const int c = lane & 3;
#pragma unroll
    for (int j = 0; j < 4; ++j) { const int nl = 16 * j + (lane >> 2), n = d.n0 + nl; const LAS float* s = scr + (16 * c) * 65 + nl;
        unsigned wd[4]; int isum = 0;
#pragma unroll
        for (int w = 0; w < 4; ++w) { int q[4];
#pragma unroll
            for (int e = 0; e < 4; ++e) { q[e] = __float2int_rn(fminf(fmaxf(s[(4 * w + e) * 65], -127.f), 127.f)); isum += q[e]; }
            wd[w] = ((unsigned)q[0] & 255u) | (((unsigned)q[1] & 255u) << 8) | (((unsigned)q[2] & 255u) << 16) | ((unsigned)q[3] << 24); }
        const u32x4 o = {wd[0], wd[1], wd[2], wd[3]};
        const int row = d.mode ? RmInA{}(n) : n + d.off;
        if (n < d.N) *(u32x4*)((unsigned char*)d.WT + (size_t)row * d.Kout + d.ko + 16 * c) = o;
        if (d.cs) {
            isum += __builtin_amdgcn_update_dpp(0, isum, 0xB1, 0xF, 0xF, true); isum += __builtin_amdgcn_update_dpp(0, isum, 0x4E, 0xF, 0xF, true);
            if (c == 0 && n < d.N) atomicAdd(d.cs + row, isum); } }
    LDS_WAIT(); asm volatile("" ::: "memory");
}
__device__ __forceinline__ float est_sigma(const float* __restrict__ W, int N, const float* __restrict__ g, int lane) {
    float s = 0.f;
#pragma unroll
    for (int r = 0; r < 4; ++r) { const float gr = g ? g[r] : 1.0f;
#pragma unroll
        for (int j = 0; j < 4; ++j) { const f32x4 v = *(const f32x4*)(W + (size_t)r * N + 256 * j + 4 * lane) * gr; s += (v[0] * v[0] + v[1] * v[1]) + (v[2] * v[2] + v[3] * v[3]); } }
    return sqrtf(wave_sum(s) * (1.0f / 4096.0f));
}
template <bool OUTF>
__device__ __forceinline__ void rms_row(const float* xrow, const float* __restrict__ g, void* orow, int lane) {
    f32x4 v[16]; float s = 0.f;
#pragma unroll
    for (int j = 0; j < 16; ++j) { v[j] = ((const f32x4*)xrow)[64 * j + lane]; s += (v[j][0] * v[j][0] + v[j][1] * v[j][1]) + (v[j][2] * v[j][2] + v[j][3] * v[j][3]); }
    s = wave_sum(s);
    const float r = 1.0f / sqrtf(s * (1.0f / 4096.0f) + EPS);
#pragma unroll
    for (int j = 0; j < 16; ++j) { const f32x4 gg = ((const f32x4*)g)[64 * j + lane]; const f32x4 y = v[j] * r * gg;
        if (OUTF) ((f32x4*)orow)[64 * j + lane] = y;
        else { u32x2 w; w.x = cvt_pk_bf16(y[0], y[1]); w.y = cvt_pk_bf16(y[2], y[3]); ((u32x2*)orow)[64 * j + lane] = w; } }
}
__device__ __forceinline__ void cast_row(const float* xrow, bf16_t* orow, unsigned char* orow8, unsigned long long* ss, int lane) {
    f32x4 v[16]; float s = 0.f;
#pragma unroll
    for (int j = 0; j < 16; ++j) { v[j] = ((const f32x4*)xrow)[64 * j + lane]; s += (v[j][0] * v[j][0] + v[j][1] * v[j][1]) + (v[j][2] * v[j][2] + v[j][3] * v[j][3]);
        u32x2 w; w.x = cvt_pk_bf16(v[j][0], v[j][1]); w.y = cvt_pk_bf16(v[j][2], v[j][3]); ((u32x2*)orow)[64 * j + lane] = w; }
    s = wave_sum(s);
    const unsigned long long sf = ss_fix(s); const float qi = QINV * ss_rstd(sf);
#pragma unroll
    for (int j = 0; j < 16; ++j) ((unsigned*)orow8)[64 * j + lane] = pk_i8(v[j][0] * qi, v[j][1] * qi, v[j][2] * qi, v[j][3] * qi);
    if (lane == 0) *ss = sf;
}
__device__ __forceinline__ void final_row(const bf16_t* xrow, const float* __restrict__ g, unsigned long long ss, float* orow, int lane) {
    const float r = ss_rstd(ss);
#pragma unroll
    for (int j = 0; j < 8; ++j) { const u32x4 w = ((const u32x4*)xrow)[64 * j + lane]; const f32x4 g0 = ((const f32x4*)g)[128 * j + 2 * lane], g1 = ((const f32x4*)g)[128 * j + 2 * lane + 1];
        const f32x4 y0 = (f32x4){__uint_as_float(w.x << 16), __uint_as_float(w.x & 0xffff0000u), __uint_as_float(w.y << 16), __uint_as_float(w.y & 0xffff0000u)} * r * g0;
        const f32x4 y1 = (f32x4){__uint_as_float(w.z << 16), __uint_as_float(w.z & 0xffff0000u), __uint_as_float(w.w << 16), __uint_as_float(w.w & 0xffff0000u)} * r * g1;
        ((f32x4*)orow)[128 * j + 2 * lane] = y0; ((f32x4*)orow)[128 * j + 2 * lane + 1] = y1; }
}
__device__ __forceinline__ void rms_phase(const Frame& F, const float* x, const float* g, bf16_t* out, int rows) {
    const int gw = F.bid * 8 + F.wave, NGW = F.G * 8;
    for (int m = gw; m < rows; m += NGW) rms_row<false>(x + (size_t)m * DM, g, out + (size_t)m * DM, F.lane);
}

__device__ __forceinline__ void select_row(const float* __restrict__ SC, unsigned long long* __restrict__ MASKT, int b, int t, int lane) {
    const int chunk = t >> 6;
    const float* row = SC + (size_t)(b * SEQ + t) * SEQ;
    unsigned long long* mo = MASKT + (size_t)b * 32 * SEQ + t;
    if (chunk < 4) { if (lane < 32) mo[(size_t)lane * SEQ] = (lane <= chunk) ? ~0ull : 0ull; return; }
    unsigned key[32];
#pragma unroll
    for (int gI = 0; gI < 4; ++gI) {
        if (gI * 8 <= chunk) {
#pragma unroll
            for (int ii = 0; ii < 8; ++ii) { const int i = gI * 8 + ii; const unsigned u = __float_as_uint(row[64 * i + lane]);
                const unsigned k = (u & 0x80000000u) ? ~u : (u | 0x80000000u); key[i] = (i <= chunk) ? k : 0u; }
        } else {
#pragma unroll
            for (int ii = 0; ii < 8; ++ii) key[gI * 8 + ii] = 0u;
        }
    }
    unsigned T = 0u; bool exact = false;
    for (int bit = 31; bit >= 0; --bit) {
        const unsigned cand = T | (1u << bit);
        int c0 = 0, c1 = 0;
#pragma unroll
        for (int gI = 0; gI < 4; ++gI) {
            if (gI * 8 <= chunk) {
#pragma unroll
                for (int ii = 0; ii < 8; ii += 2) { c0 += (key[gI * 8 + ii] >= cand) ? 1 : 0; c1 += (key[gI * 8 + ii + 1] >= cand) ? 1 : 0; }
            }
        }
        const int cnt = wave_isum(c0 + c1);
        if (cnt >= 256) T = cand;
        if (cnt == 256) { exact = true; break; }
    }
    if (exact) {
        unsigned long long myw = 0ull;
#pragma unroll
        for (int i = 0; i < 32; ++i) { const unsigned long long w = __ballot(key[i] >= T); myw = (lane == i) ? w : myw; }
        if (lane < 32) mo[(size_t)lane * SEQ] = myw;
        return; }
    int cgt = 0;
#pragma unroll
    for (int i = 0; i < 32; ++i) cgt += __popcll(__ballot(key[i] > T));
    const int need = 256 - cgt;
    int run = 0; unsigned long long myword = 0ull;
#pragma unroll
    for (int i = 0; i < 32; ++i) {
        const unsigned long long tie = __ballot(key[i] == T), gt = __ballot(key[i] > T);
        const int nt = __popcll(tie), take = need - run;
        unsigned long long sel = 0ull;
        if (take >= nt) sel = tie;
        else if (take > 0) { unsigned long long m = tie; for (int q = 0; q < take; ++q) { const unsigned long long lb = m & (0ull - m); sel |= lb; m ^= lb; } }
        run += nt;
        const unsigned long long w = gt | sel;
        myword = (lane == i) ? w : myword;
    }
    if (lane < 32) mo[(size_t)lane * SEQ] = myword;
}

__device__ __forceinline__ void indexer_unit(LAS unsigned char* lds, const bf16_t* __restrict__ QI, const bf16_t* __restrict__ KI, const float* __restrict__ WI, float* SC, unsigned long long* __restrict__ MASKT, int b, int qb, int tid) {
    const int wid = tid >> 6, lane = tid & 63, r32 = lane & 31, hf = lane >> 5;
    const int t0 = qb * 16, NP = (qb >> 2) + 1;
    LAS unsigned char* kbuf = lds;
    LAS float* wiT = (LAS float*)(lds + 32768);
    __syncthreads();
    for (int e = tid; e < 512; e += 512) { const int tl = e >> 5, h2 = (e >> 4) & 1, r = e & 15, head = (r & 3) + 8 * (r >> 2) + 4 * h2;
        wiT[e] = WI[(size_t)(b * SEQ + t0 + tl) * 32 + head]; }
    bf16x8 qa[2][8];
#pragma unroll
    for (int i = 0; i < 2; ++i) { const bf16_t* qp = QI + (size_t)(b * SEQ + t0 + wid + 8 * i) * 4096 + r32 * 128 + hf * 8;
#pragma unroll
        for (int s = 0; s < 8; ++s) qa[i][s] = *(const bf16x8*)(qp + 16 * s); }
    const int sr = tid >> 4, scb = (tid & 15) * 16;
    const bf16_t* kg = KI + (size_t)(b * SEQ) * 128 + (tid & 15) * 8;
    bf16x8 st0, st1;
#define ILOAD(k0) do { st0 = *(const bf16x8*)(kg + (size_t)((k0) + sr) * 128); st1 = *(const bf16x8*)(kg + (size_t)((k0) + 32 + sr) * 128); } while (0)
#define IWRITE(buf) do { *(LAS bf16x8*)(kbuf + (buf) * 16384 + KSWZ(sr, scb)) = st0; *(LAS bf16x8*)(kbuf + (buf) * 16384 + KSWZ(32 + sr, scb)) = st1; } while (0)
    ILOAD(0); IWRITE(0); __syncthreads();
    for (int jp = 0; jp < NP; ++jp) {
        if (jp + 1 < NP) ILOAD((jp + 1) * 64);
        const LAS unsigned char* kb_ = kbuf + (jp & 1) * 16384;
        float pa[2], pb[2];
#pragma unroll
        for (int a = 0; a < 2; ++a) {
            bf16x8 kf[8];
#pragma unroll
            for (int s = 0; s < 8; ++s) kf[s] = *(const LAS bf16x8*)(kb_ + KSWZ(32 * a + r32, (16 * s + 8 * hf) * 2));
#pragma unroll
            for (int i = 0; i < 2; ++i) {
                f32x16 d = {};
#pragma unroll
                for (int s = 0; s < 8; ++s) d = __builtin_amdgcn_mfma_f32_32x32x16_bf16(qa[i][s], kf[s], d, 0, 0, 0);
                const LAS f32x4* wp = (const LAS f32x4*)(wiT + ((wid + 8 * i) * 2 + hf) * 16);
                const f32x4 w0 = wp[0], w1 = wp[1], w2 = wp[2], w3 = wp[3];
                float p = 0.f;
#pragma unroll
                for (int r = 0; r < 4; ++r) { p = fmaf(w0[r], fmaxf(d[r], 0.f), p); p = fmaf(w1[r], fmaxf(d[4 + r], 0.f), p); p = fmaf(w2[r], fmaxf(d[8 + r], 0.f), p); p = fmaf(w3[r], fmaxf(d[12 + r], 0.f), p); }
                if (a == 0) pa[i] = p; else pb[i] = p;
            }
        }
#pragma unroll
        for (int i = 0; i < 2; ++i) { auto rr = __builtin_amdgcn_permlane32_swap(__float_as_uint(pa[i]), __float_as_uint(pb[i]), false, false);
            SC[(size_t)(b * SEQ + t0 + wid + 8 * i) * SEQ + 64 * jp + lane] = __uint_as_float(rr[0]) + __uint_as_float(rr[1]); }
        if (jp + 1 < NP) IWRITE((jp + 1) & 1);
        __syncthreads();
    }
#undef ILOAD
#undef IWRITE
    asm volatile("s_waitcnt vmcnt(0)" ::: "memory");
    _Pragma("nounroll") for (int i = 0; i < 2; ++i) select_row(SC, MASKT, b, t0 + wid + 8 * i, lane);
}

__device__ __forceinline__ unsigned char* launder(unsigned char* p) { size_t z = 0; asm volatile("" : "+s"(z)); return p + z; }
#define WSP(T, off) ((T*)(ws + (off)))
#define PHASE_BEGIN() unsigned char* ws = launder(args.ws); Frame F; F.lds = (LAS unsigned char*)lds_raw; { int t_ = (wv0 << 6) | hw_lane(); asm volatile("" : "+v"(t_)); F.tid = t_; int b_ = blockIdx.x; asm volatile("" : "+s"(b_)); F.bid = b_; } F.lane = F.tid & 63; F.wave = __builtin_amdgcn_readfirstlane(F.tid >> 6); F.G = gridDim.x; F.ws = ws
#define GRID_BAR() do { unsigned char* wsb = launder(args.ws); XcdBarrier bar_; bar_.bar = (unsigned*)(wsb + WS_CTL) + CW_BAR; bar_.x = xb_xcc_id(); bar_.st = (volatile LAS unsigned*)((LAS unsigned char*)lds_raw + MISC_OFF); bar_.lead = (wv0 == 0) && (hw_lane() == 0); xcd_barrier(bar_); } while (0)

template <int L> __device__ __forceinline__ void layer_fwd(const Args& args, unsigned char* lds_raw, const int wv0) {
        if constexpr (L == 0) {
DUP(9,
            { PHASE_BEGIN();
              { pg8::Gemm g{WSP(bf16_t, WS_X8), WSP(bf16_t, WS_WA_IN8), MTOK, 6144, DM, 0}; pg8::StaticOrder S; S.init(MTOK, 6144, F.G, F.bid);
                pg8::EpiInA E{WSP(bf16_t, WS_Q), WSP(bf16_t, WS_K0), WSP(bf16_t, WS_V0), WSP(bf16_t, WS_QI), WSP(bf16_t, WS_KI), WSP(float, WS_WI), WSP(float, WS_COS), WSP(float, WS_SIN), nullptr, 0, QMUL * ((const float*)(ws + WS_QS))[4]};
                pg8::gemm_phase<pg8::EpiInA, pg8::StaticOrder, true, true, 2>(F.lds, g, S, E, F.tid); }
              { pg8::Gemm g{WSP(bf16_t, WS_HN), WSP(bf16_t, WS_WA_IN) + (size_t)6144 * DM, MTOK, A_IN_PAD - 6144, DM, 0}; pg8::StaticOrder S; S.init(MTOK, A_IN_PAD - 6144, F.G, F.bid);
                pg8::EpiInA E{WSP(bf16_t, WS_Q), WSP(bf16_t, WS_K0), WSP(bf16_t, WS_V0), WSP(bf16_t, WS_QI), WSP(bf16_t, WS_KI), WSP(float, WS_WI), WSP(float, WS_COS), WSP(float, WS_SIN), SSP(0), 48, 1.0f};
                pg8::gemm_phase<pg8::EpiInA, pg8::StaticOrder, true, true>(F.lds, g, S, E, F.tid); }
              for (int l2 = 0; l2 < 2; ++l2) {
                pg8::Gemm g{WSP(bf16_t, WS_MEMN), WSP(bf16_t, WS_WMKV) + (size_t)l2 * 1024 * DM, BATCH * MEMT, 1024, DM, 0}; pg8::StaticOrder S; S.init(BATCH * MEMT, 1024, F.G, (F.bid + F.G - 64 - 32 * l2) % F.G);
                pg8::EpiBf16<0> E{WSP(bf16_t, WS_MKV) + (size_t)l2 * BATCH * MEMT * 1024, 1024, 0, 0, nullptr, 1.0f, nullptr, nullptr};
                pg8::gemm_phase<pg8::EpiBf16<0>, pg8::StaticOrder, true, true>(F.lds, g, S, E, F.tid); } }
            GRID_BAR();
)
DUP(2,
            { PHASE_BEGIN();
              for (int u = F.bid; u < 512; u += F.G) { const int b = u & 7, j = u >> 3;
                for (int k2 = 0; k2 < 2; ++k2) indexer_unit(F.lds, WSP(bf16_t, WS_QI), WSP(bf16_t, WS_KI), WSP(float, WS_WI), WSP(float, WS_SC), WSP(unsigned long long, WS_MASK), b, k2 ? 127 - j : j, F.tid); } }
            GRID_BAR();
)
DUP(4,
            { PHASE_BEGIN();
              bf16_t* Qb = WSP(bf16_t, WS_Q); const bf16_t* K0 = WSP(bf16_t, WS_K0); const bf16_t* V0 = WSP(bf16_t, WS_V0); const unsigned long long* MASKT = WSP(unsigned long long, WS_MASK);
              for (int pu = F.bid; pu < 1024; pu += F.G) {
                const int xcd = pu & 7, slot = (pu >> 3) & 31, rnd = pu >> 8;
                const int combo = xcd * 8 + 2 * rnd + (slot >> 4), pair = slot & 15, b = combo >> 3, kvh = combo & 7;
                for (int hh = 0; hh < 2; ++hh) { const int c = hh ? 31 - pair : pair;
                    const int nvalid = c + 1, NT = (nvalid + 1) & ~1;
                    const int hq = kvh * 4 + (F.wave >> 1), tok0 = 64 * c + 32 * (F.wave & 1), r32 = F.lane & 31, hi = F.lane >> 5;
                    const bf16_t* Qw = Qb + (size_t)(b * SEQ + tok0 + r32) * 4096 + hq * 128 + hi * 8;
                    const bf16_t* Kh = K0 + (size_t)(b * SEQ) * 1024 + kvh * 128; const bf16_t* Vh = V0 + (size_t)(b * SEQ) * 1024 + kvh * 128;
                    bf16_t* Ow = (bf16_t*)(WSP(unsigned char, WS_O) + (size_t)(b * SEQ + tok0) * 4096 + hq * 128);
                    const unsigned long long* mcol = MASKT + (size_t)b * 32 * SEQ + tok0;
                    __syncthreads();
                    att::attn_body<0, 4096, 1024, 4096, true>(Qw, Kh, Vh, Ow, NT, nvalid, mcol, 0, 0, 0, (LAS char*)F.lds, F.tid); }
              } }
            GRID_BAR();
)
        } else {
DUP(10,
            { PHASE_BEGIN();
              pg8::Gemm g{WSP(bf16_t, WS_X8), WSP(bf16_t, WS_WB_IN), MTOK, B_IN, DM, 0}; pg8::StaticOrder S; S.init(MTOK, B_IN, F.G, F.bid);
              pg8::EpiBf16<0> E{WSP(bf16_t, WS_Q), 4096, 4096, (size_t)(WS_K1 - WS_Q) / 2, SSP(3), QMUL * ((const float*)(ws + WS_QS))[5], nullptr, SSP(2)};
              pg8::gemm_phase<pg8::EpiBf16<0>, pg8::StaticOrder, true, true, 2>(F.lds, g, S, E, F.tid); }
            GRID_BAR();
)
DUP(5,
            { PHASE_BEGIN();
              bf16_t* Qb = WSP(bf16_t, WS_Q); const bf16_t* K1 = WSP(bf16_t, WS_K1); const bf16_t* V1 = WSP(bf16_t, WS_V1);
              for (int bh = F.bid; bh < 256; bh += F.G) { const int b = bh >> 5, h = bh & 31;
                __syncthreads();
                { LAS float* bt = (LAS float*)(F.lds + att::OFF_BT); const float* rb = args.in[10] + (size_t)h * 513;
                  for (int uI = F.tid; uI < 1024; uI += 512) { int rel = 767 - uI; rel = rel < -256 ? -256 : (rel > 256 ? 256 : rel); bt[uI] = rb[rel + 256] * 1.4426950408889634f; } }
                for (int cg = 0; cg < 8; ++cg) {
                    const int tlo = (4 * cg - 8) > 0 ? (4 * cg - 8) : 0, NT = 4 * cg + 4 - tlo;
                    const int cw = 4 * cg + (F.wave >> 1), r32 = F.lane & 31, hi = F.lane >> 5;
                    const int qpos = 64 * cw + 32 * (F.wave & 1) + r32;
                    const int jlo = ((cw - 8) > 0 ? (cw - 8) : 0) - tlo, jhi = cw - tlo;
                    const bf16_t* Qw = Qb + (size_t)(b * SEQ + qpos) * 4096 + h * 128 + hi * 8;
                    const bf16_t* Kh = K1 + (size_t)(b * SEQ + 64 * tlo) * 4096 + h * 128; const bf16_t* Vh = V1 + (size_t)(b * SEQ + 64 * tlo) * 4096 + h * 128;
                    bf16_t* Ow = (bf16_t*)(WSP(unsigned char, WS_O) + (size_t)(b * SEQ + 64 * cw + 32 * (F.wave & 1)) * 4096 + h * 128);
                    const int bb0 = 767 - qpos + 64 * tlo + 4 * hi;
                    __syncthreads();
                    att::attn_body<1, 4096, 4096, 4096, true>(Qw, Kh, Vh, Ow, NT, NT, nullptr, jlo, jhi, bb0, (LAS char*)F.lds, F.tid); }
              } }
            GRID_BAR();
)
        }
DUP(13,
        { PHASE_BEGIN();
          pg8::Gemm g{WSP(bf16_t, WS_O), L ? WSP(bf16_t, WS_WB_OUT) : WSP(bf16_t, WS_WA_OUT), MTOK, DM, DM, 0}; pg8::StaticOrder S; S.init(MTOK, DM, F.G, F.bid);
          pg8::EpiResB<false> E{nullptr, WSP(bf16_t, WS_HN), dup_ ? SSD : SSP(1 + 3 * L), dup_ ? 0.0f : 1.0f / 1024.0f, nullptr, nullptr, (LAS float*)(F.lds + 131072)};
          pg8::gemm_phase<pg8::EpiResB<false>, pg8::StaticOrder, true, true, true>(F.lds, g, S, E, F.tid); }
        GRID_BAR();
)
DUP(12,
        { PHASE_BEGIN();
          pg8::Gemm g{WSP(bf16_t, WS_HN), WSP(bf16_t, WS_WMQ) + (size_t)L * MEMD * DM, MTOK, MEMD, DM, 0}; pg8::StaticOrder S; S.init(MTOK, MEMD, F.G, F.bid);
          pg8::EpiBf16<0> E{WSP(bf16_t, WS_MQ), MEMD, 0, 0, SSP(1 + 3 * L), 1.0f, nullptr, nullptr};
          pg8::gemm_phase<pg8::EpiBf16<0>, pg8::StaticOrder, true, true>(F.lds, g, S, E, F.tid); }
        GRID_BAR();
)
DUP(6,
        { PHASE_BEGIN();
          bf16_t* MQ = WSP(bf16_t, WS_MQ); const bf16_t* MKV = WSP(bf16_t, WS_MKV) + (size_t)L * BATCH * MEMT * 1024;
          for (int u = F.bid; u < 256; u += F.G) { const int b = u >> 5, mh = (u >> 3) & 3, tb = u & 7;
            const int r32 = F.lane & 31, hi = F.lane >> 5;
            const bf16_t* Qw = MQ + (size_t)(b * SEQ + 256 * tb + 32 * F.wave + r32) * MEMD + mh * 128 + hi * 8;
            const bf16_t* Kh = MKV + (size_t)(b * MEMT) * 1024 + mh * 128; const bf16_t* Vh = Kh + 512;
            bf16_t* Ow = WSP(bf16_t, WS_MO) + (size_t)(b * SEQ + 256 * tb + 32 * F.wave) * MEMD + mh * 128;
            __syncthreads();
            att::attn_body<2, MEMD, 1024, MEMD>(Qw, Kh, Vh, Ow, 4, 4, nullptr, 0, 0, 0, (LAS char*)F.lds, F.tid); } }
        GRID_BAR();
)
DUP(14,
        { PHASE_BEGIN();
          pg8::Gemm g{WSP(bf16_t, WS_MO), WSP(bf16_t, WS_WMO) + (size_t)L * DM * MEMD, MTOK, DM, MEMD, 0}; pg8::StaticOrder S; S.init(MTOK, DM, F.G, F.bid);
          pg8::EpiResB<false, 2> E{nullptr, WSP(bf16_t, WS_HN), dup_ ? SSD : SSP(2 + 3 * L), dup_ ? 0.0f : 1.0f, SSP(1 + 3 * L), nullptr, (LAS float*)(F.lds + 131072)};
          pg8::gemm_phase<pg8::EpiResB<false, 2>, pg8::StaticOrder, true, true>(F.lds, g, S, E, F.tid); }
        GRID_BAR();
)
DUP(7,
        { PHASE_BEGIN();
          pg8::Gemm g{WSP(bf16_t, WS_X8), WSP(bf16_t, WS_WUP) + (size_t)L * DFF * DM, MTOK, DFF, DM, 0}; pg8::StaticOrder S; S.init(MTOK, DFF, F.G, F.bid, pg8::WGM_UP);
          const float qs_up = ((const float*)(ws + WS_QS))[L], sig_z = 64.0f * qs_up * (1.0f / QMUL), a_clip = (C_A * sig_z) * (C_A * sig_z);
          pg8::EpiHidI8 E{WSP(unsigned char, WS_A1), DFF, SSP(2 + 3 * L), QMUL * qs_up * (15.968719422671311f / (C_A * sig_z)), SSP(1 + 3 * L), 255.0f / a_clip};
          pg8::gemm_phase<pg8::EpiHidI8, pg8::StaticOrder, true, true, 2>(F.lds, g, S, E, F.tid); }
        GRID_BAR();
)
DUP(15,
        { PHASE_BEGIN();
          const float* qs = (const float*)(ws + WS_QS); const float sig_z = 64.0f * qs[L] * (1.0f / QMUL), a_clip = (C_A * sig_z) * (C_A * sig_z);
          pg8::Gemm g{WSP(bf16_t, WS_A1), WSP(bf16_t, WS_WDN) + (size_t)L * DM * DFF, MTOK, DM, DFF, 0}; pg8::StaticOrder S; S.init(MTOK, DM, F.G, F.bid, pg8::WGM_DN);
          pg8::EpiResB<false, L == 0 ? 2 : 0, false, true> E{nullptr, WSP(bf16_t, WS_HN), dup_ ? SSD : SSP(3 + 3 * L), dup_ ? 0.0f : a_clip * (1.0f / 255.0f) * qs[2 + L], SSP(2 + 3 * L), (const int*)(ws + WS_CS) + L * DM, (LAS float*)(F.lds + 131072)};
          pg8::gemm_phase<pg8::EpiResB<false, L == 0 ? 2 : 0, false, true>, pg8::StaticOrder, true, true, 2>(F.lds, g, S, E, F.tid); }
        GRID_BAR();
)
}

__global__ void __launch_bounds__(512, 2) trunk_fwd(Args args) {
    extern __shared__ __attribute__((aligned(16))) unsigned char lds_raw[];
    const int wv0 = __builtin_amdgcn_readfirstlane((int)(threadIdx.x >> 6));
    {
        volatile LAS unsigned* MISC = (volatile LAS unsigned*)((LAS unsigned char*)lds_raw + MISC_OFF);
        if (threadIdx.x < 16) MISC[threadIdx.x] = 0u;
        __syncthreads();
        (void)xcd_barrier_post((unsigned*)(args.ws + WS_CTL) + CW_BAR, MISC);
    }

DUP(0,
    {
        PHASE_BEGIN();
        LAS float* scr = (LAS float*)(F.lds + F.wave * 16640);
        const int gw = F.bid * 8 + F.wave, NGW = F.G * 8;
        constexpr int T_INA = 64 * 163, T_OUT = 64 * 64, T_INB = 64 * 192, T_M = 2 * 64 * 8, T_MO = 2 * 8 * 64, T_UP = 2 * 64 * 256, T_DN = 2 * 256 * 64;
        constexpr int NITEMS = T_INA + T_OUT + T_INB + T_OUT + 3 * T_M + T_MO + T_UP + T_DN;
        const float sig_up0 = est_sigma(args.in[16], DFF, args.in[4], F.lane), sig_up1 = est_sigma(args.in[16] + (size_t)DM * DFF, DFF, args.in[4] + DM, F.lane);
        const float sig_dn0 = est_sigma(args.in[17], DM, nullptr, F.lane), sig_dn1 = est_sigma(args.in[17] + (size_t)DFF * DM, DM, nullptr, F.lane);
        const float sig_ina = est_sigma(args.in[7], A_IN, args.in[2], F.lane), sig_inb = est_sigma(args.in[9], B_IN, args.in[2] + DM, F.lane);
        if (gw == 0 && F.lane == 0) { float* qs = (float*)(ws + WS_QS); qs[0] = sig_up0 * QMUL; qs[1] = sig_up1 * QMUL; qs[2] = sig_dn0 * QMUL; qs[3] = sig_dn1 * QMUL; qs[4] = sig_ina * QMUL; qs[5] = sig_inb * QMUL; }
        auto decode = [&](int it) -> CvtDesc {
            CvtDesc d; int r = it; d.mode = 0; d.off = 0; d.gk = nullptr; d.f8 = 0; d.wsc = 64.0f; d.Kout = -1; d.ko = 0; d.cs = nullptr;
            if (r < T_INA) { d.W = args.in[7]; d.K = DM; d.N = A_IN; d.WT = WSP(bf16_t, WS_WA_IN); d.mode = 1; d.gk = args.in[2]; d.k0 = 64 * (2 * (r / 326) + (r & 1)); d.n0 = 64 * ((r % 326) >> 1);
                if (d.n0 < 6144) { d.f8 = 2; d.wsc = QINV / sig_ina; d.WT = WSP(bf16_t, WS_WA_IN8); }
                return d; } r -= T_INA;
            if (r < T_OUT) { d.W = args.in[8]; d.K = DM; d.N = DM; d.WT = WSP(bf16_t, WS_WA_OUT); d.f8 = 1; d.k0 = 64 * (2 * (r / 128) + (r & 1)); d.n0 = 64 * ((r % 128) >> 1); return d; } r -= T_OUT;
            if (r < T_INB) { d.W = args.in[9]; d.K = DM; d.N = B_IN; d.WT = WSP(bf16_t, WS_WB_IN); d.f8 = 2; d.wsc = QINV / sig_inb; d.gk = args.in[2] + DM; d.k0 = 64 * (2 * (r / 384) + (r & 1)); d.n0 = 64 * ((r % 384) >> 1); return d; } r -= T_INB;
            if (r < T_OUT) { d.W = args.in[11]; d.K = DM; d.N = DM; d.WT = WSP(bf16_t, WS_WB_OUT); d.f8 = 1; d.k0 = 64 * (2 * (r / 128) + (r & 1)); d.n0 = 64 * ((r % 128) >> 1); return d; } r -= T_OUT;
            if (r < T_M) { const int L = r / 512, q = r % 512; d.W = args.in[12] + (size_t)L * DM * MEMD; d.K = DM; d.N = MEMD; d.WT = WSP(bf16_t, WS_WMQ) + (size_t)L * MEMD * DM; d.gk = args.in[3] + (size_t)L * DM; d.k0 = 64 * (q / 8); d.n0 = 64 * (q % 8); return d; } r -= T_M;
            if (r < T_M) { const int L = r / 512, q = r % 512; d.W = args.in[13] + (size_t)L * DM * MEMD; d.K = DM; d.N = MEMD; d.WT = WSP(bf16_t, WS_WMKV) + (size_t)L * 1024 * DM; d.k0 = 64 * (q / 8); d.n0 = 64 * (q % 8); return d; } r -= T_M;
            if (r < T_M) { const int L = r / 512, q = r % 512; d.W = args.in[14] + (size_t)L * DM * MEMD; d.K = DM; d.N = MEMD; d.WT = WSP(bf16_t, WS_WMKV) + (size_t)L * 1024 * DM; d.off = 512; d.k0 = 64 * (q / 8); d.n0 = 64 * (q % 8); return d; } r -= T_M;
            if (r < T_MO) { const int L = r / 512, q = r % 512; d.W = args.in[15] + (size_t)L * MEMD * DM; d.K = MEMD; d.N = DM; d.WT = WSP(bf16_t, WS_WMO) + (size_t)L * DM * MEMD; d.k0 = 64 * (q / 64); d.n0 = 64 * (q % 64); return d; } r -= T_MO;
            if (r < T_UP) { const int L = r / 16384, q = r % 16384; d.W = args.in[16] + (size_t)L * DM * DFF; d.K = DM; d.N = DFF; d.WT = WSP(bf16_t, WS_WUP) + (size_t)L * DFF * DM; d.gk = args.in[4] + (size_t)L * DM; d.k0 = 64 * (2 * (q / 512) + (q & 1)); d.n0 = 64 * ((q % 512) >> 1);
              d.f8 = 2; d.wsc = QINV / (L ? sig_up1 : sig_up0);
              return d; } r -= T_UP;
            { const int L = r / 16384, q = r % 16384; d.W = args.in[17] + (size_t)L * DFF * DM; d.K = DFF; d.N = DM; d.WT = WSP(bf16_t, WS_WDN) + (size_t)L * DM * DFF; d.k0 = 64 * (2 * (q / 128) + (q & 1)); d.n0 = 64 * ((q % 128) >> 1);
              d.f8 = 2; d.wsc = QINV / (L ? sig_dn1 : sig_dn0); d.cs = dup_ ? nullptr : (int*)(ws + WS_CS) + L * DM;
              return d; }
        };
        { f32x4 va[16], vb[16]; CvtDesc da, db; int it = gw;
          auto dec2 = [&](int t) -> CvtDesc { CvtDesc d = decode(t); if (d.Kout < 0) { d.Kout = d.K; d.ko = d.k0; } return d; };
          if (it < NITEMS) { da = dec2(it); cvt_load(da, va, F.lane); }
          while (it < NITEMS) {
              const int it2 = it + NGW; const bool h2 = it2 < NITEMS;
              if (h2) { db = dec2(it2); cvt_load(db, vb, F.lane); }
              if (da.f8 == 2) cvt_store_i8(da, va, scr, F.lane); else if (da.f8) cvt_store_f8(da, va, scr, F.lane); else cvt_store(da, va, scr, F.lane);
              if (!h2) break;
              const int it3 = it2 + NGW; const bool h3 = it3 < NITEMS;
              if (h3) { da = dec2(it3); cvt_load(da, va, F.lane); }
              if (db.f8 == 2) cvt_store_i8(db, vb, scr, F.lane); else if (db.f8) cvt_store_f8(db, vb, scr, F.lane); else cvt_store(db, vb, scr, F.lane);
              it = it3; } }
        { u32x4* p = (u32x4*)(WSP(bf16_t, WS_WA_IN) + (size_t)A_IN * DM); const int n16 = (A_IN_PAD - A_IN) * DM * 2 / 16;
          for (int i = F.bid * 512 + F.tid; i < n16; i += F.G * 512) p[i] = (u32x4){0u, 0u, 0u, 0u}; }
        { float* COS = WSP(float, WS_COS); float* SIN = WSP(float, WS_SIN);
          for (int i = F.bid * 512 + F.tid; i < SEQ * 64; i += F.G * 512) { const int pos = i >> 6, fi = i & 63;
            const float inv = __builtin_amdgcn_exp2f(-(float)fi * (13.287712379549449f / 64.0f));
            double rev = (double)pos * (double)inv * 0.15915494309189535; rev -= __builtin_rint(rev);
            const float fr = (float)rev; COS[i] = __builtin_amdgcn_cosf(fr); SIN[i] = __builtin_amdgcn_sinf(fr); } }
        for (int m = gw; m < BATCH * MEMT; m += NGW) rms_row<false>(args.in[1] + (size_t)m * DM, args.in[5], WSP(bf16_t, WS_MEMN) + (size_t)m * DM, F.lane);
        for (int m = gw; m < MTOK; m += NGW) cast_row(args.in[0] + (size_t)m * DM, WSP(bf16_t, WS_HN) + (size_t)m * DM, WSP(unsigned char, WS_X8) + (size_t)m * DM, SSP(0) + m, F.lane);
    }
    GRID_BAR();
)

    layer_fwd<0>(args, lds_raw, wv0);
    layer_fwd<1>(args, lds_raw, wv0);
    { PHASE_BEGIN();
      for (int m = F.bid * 8 + F.wave; m < MTOK; m += F.G * 8) final_row(WSP(bf16_t, WS_HN) + (size_t)m * DM, args.in[6], SSP(6)[m], args.out + (size_t)m * DM, F.lane); }
}

extern "C" void kernel_launch(void* const* d_in, const int* in_sizes, int n_in, void* d_out, int out_size, void* d_ws, size_t ws_size, hipStream_t stream) {
    static int grid = 0;
    if (grid == 0) {
        if (n_in != 18 || in_sizes[0] != MTOK * DM || out_size != MTOK * DM || ws_size < WS_END) {
            fprintf(stderr, "kernel_launch: unexpected shapes: n_in %d in0 %d out %d ws %zu (need %zu)\n", n_in, n_in > 0 ? in_sizes[0] : -1, out_size, ws_size, (size_t)WS_END); grid = -1; return; }
        int dev = 0, cus = 0, per_cu = 0;
        if (hipGetDevice(&dev) != hipSuccess || hipDeviceGetAttribute(&cus, hipDeviceAttributeMultiprocessorCount, dev) != hipSuccess) { grid = -1; return; }
        if (hipFuncSetAttribute((const void*)trunk_fwd, hipFuncAttributeMaxDynamicSharedMemorySize, LDS_BYTES) != hipSuccess) { fprintf(stderr, "kernel_launch: hipFuncSetAttribute failed\n"); grid = -1; return; }
        if (hipOccupancyMaxActiveBlocksPerMultiprocessor(&per_cu, (const void*)trunk_fwd, 512, LDS_BYTES) != hipSuccess || per_cu < 1) { fprintf(stderr, "kernel_launch: occupancy query says %d\n", per_cu); }
        (void)hipGetLastError();
        grid = cus;
    }
    if (grid < 0) return;
    (void)hipMemsetAsync((char*)d_ws + WS_CTL, 0, CTL_ZERO_BYTES, stream);
    Args a{};
    for (int i = 0; i < 18; ++i) a.in[i] = (const float*)d_in[i];
    a.out = (float*)d_out; a.ws = (unsigned char*)d_ws;
    hipLaunchKernelGGL(trunk_fwd, dim3(grid), dim3(512), LDS_BYTES, stream, a);
    const hipError_t le = hipPeekAtLastError();
    if (le != hipSuccess) fprintf(stderr, "kernel_launch: launch failed: %s\n", hipGetErrorName(le));
}
```

```cpp
#include <hip/hip_runtime.h>
#include <cstdio>
#include <cstdint>

#define LAS __attribute__((address_space(3)))
typedef unsigned short bf16_t;
typedef short bf16x8 __attribute__((ext_vector_type(8)));
typedef short s16x4 __attribute__((ext_vector_type(4)));
typedef float f32x4 __attribute__((ext_vector_type(4)));
typedef float f32x16 __attribute__((ext_vector_type(16)));
typedef unsigned u32x4 __attribute__((ext_vector_type(4)));
typedef unsigned u32x2 __attribute__((ext_vector_type(2)));
typedef int v4i_t __attribute__((ext_vector_type(4)));
typedef int v8i_t __attribute__((ext_vector_type(8)));

#ifndef PROBE_MASK
#define PROBE_MASK 0
#endif
#define DUP(k, ...) do { { constexpr int dup_ = 0; (void)dup_; __VA_ARGS__ } if constexpr (((PROBE_MASK >> (k)) & 1) != 0) { constexpr int dup_ = 1; (void)dup_; __VA_ARGS__ } } while (0);
constexpr int BATCH = 8, SEQ = 2048, DM = 4096, MTOK = BATCH * SEQ;
constexpr int A_IN = 10400, A_IN_PAD = 10496;
constexpr int B_IN = 12288, DFF = 16384, MEMT = 256, MEMD = 512;
constexpr float EPS = 1e-6f;

constexpr size_t MiB = 1u << 20;
constexpr size_t WS_CTL = 0, CTL_ZERO_BYTES = 1 * MiB;
constexpr size_t WS_COS = 1 * MiB, WS_SIN = WS_COS + 512 * 1024;
constexpr size_t WS_WA_IN = 2 * MiB;
constexpr size_t WS_WA_OUT = 84 * MiB;
constexpr size_t WS_WB_IN = 116 * MiB;
constexpr size_t WS_WB_OUT = 212 * MiB;
constexpr size_t WS_WMQ = 244 * MiB;
constexpr size_t WS_WMKV = 252 * MiB;
constexpr size_t WS_WMO = 268 * MiB;
constexpr size_t WS_WUP = 276 * MiB;
constexpr size_t WS_WDN = 532 * MiB;
constexpr size_t WS_HN = 788 * MiB;
constexpr size_t WS_MEMN = 916 * MiB;
constexpr size_t WS_MKV = 932 * MiB;
constexpr size_t WS_MQ = 940 * MiB;
constexpr size_t WS_MASK = 956 * MiB;
constexpr size_t WS_KI = 960 * MiB;
constexpr size_t WS_WI = 964 * MiB;
constexpr size_t WS_BIG = 968 * MiB;
constexpr size_t WS_Q = WS_BIG;
constexpr size_t WS_K0 = WS_BIG + 128 * MiB;
constexpr size_t WS_V0 = WS_BIG + 160 * MiB;
constexpr size_t WS_QI = WS_BIG + 192 * MiB;
constexpr size_t WS_SC = WS_BIG + 320 * MiB;
constexpr size_t WS_K1 = WS_BIG + 128 * MiB;
constexpr size_t WS_V1 = WS_BIG + 256 * MiB;
constexpr size_t WS_A1 = WS_BIG;
constexpr size_t WS_O = WS_BIG + 512 * MiB;
constexpr size_t WS_MO = WS_O + 128 * MiB;
constexpr size_t WS_X8 = WS_MO + 16 * MiB;
constexpr size_t WS_WA_IN8 = WS_X8 + 64 * MiB;
constexpr size_t WS_END = WS_WA_IN8 + 24 * MiB;
constexpr size_t WS_CS = 960 * 1024;
constexpr float C_A = 4.5f;
constexpr size_t WS_QS = 1000 * 1024;
constexpr float KQ = 4.25f, QINV = 127.0f / KQ, QMUL = KQ / 127.0f;
constexpr size_t X8_DELTA = WS_X8 - WS_HN;
constexpr int CW_BAR = 4096;
constexpr size_t WS_SS = 64 * 1024;
#define SSP(i) ((unsigned long long*)(ws + WS_SS + (size_t)(i) * 131072))
#define SSD WSP(unsigned long long, WS_MASK)
__device__ __forceinline__ unsigned long long ss_fix(float s) { return (unsigned long long)(long long)(s * 16777216.0f); }
__device__ __forceinline__ float ss_mean(unsigned long long v) { return ((float)(unsigned)(v >> 32) * 4294967296.0f + (float)(unsigned)v) * (1.0f / (16777216.0f * 4096.0f)) + EPS; }
__device__ __forceinline__ float ss_rms(unsigned long long v) { return __builtin_amdgcn_sqrtf(ss_mean(v)); }
__device__ __forceinline__ float ss_rstd(unsigned long long v) { return __builtin_amdgcn_rsqf(ss_mean(v)); }

constexpr int LDS_BYTES = 147456;
constexpr int MISC_OFF = LDS_BYTES - 64;

__device__ __forceinline__ unsigned cvt_pk_bf16(float lo, float hi) { unsigned r; asm volatile("v_cvt_pk_bf16_f32 %0, %1, %2" : "=v"(r) : "v"(lo), "v"(hi)); return r; }
__device__ __forceinline__ unsigned cvt_pk_fp8(float a, float b, float c, float d) { unsigned w = 0; w = __builtin_amdgcn_cvt_pk_fp8_f32(a, b, w, false); w = __builtin_amdgcn_cvt_pk_fp8_f32(c, d, w, true); return w; }
__device__ __forceinline__ unsigned pk_i8(float a, float b, float c, float d) {
    const int ia = __float2int_rn(fminf(fmaxf(a, -127.f), 127.f)), ib = __float2int_rn(fminf(fmaxf(b, -127.f), 127.f)), ic = __float2int_rn(fminf(fmaxf(c, -127.f), 127.f)), id = __float2int_rn(fminf(fmaxf(d, -127.f), 127.f));
    return ((unsigned)ia & 255u) | (((unsigned)ib & 255u) << 8) | (((unsigned)ic & 255u) << 16) | ((unsigned)id << 24);
}
__device__ __forceinline__ float wave_sum(float v) {
    v += __builtin_bit_cast(float, __builtin_amdgcn_update_dpp(0, __builtin_bit_cast(int, v), 0xB1, 0xF, 0xF, true));
    v += __builtin_bit_cast(float, __builtin_amdgcn_update_dpp(0, __builtin_bit_cast(int, v), 0x4E, 0xF, 0xF, true));
    v += __builtin_bit_cast(float, __builtin_amdgcn_update_dpp(0, __builtin_bit_cast(int, v), 0x141, 0xF, 0xF, true));
    v += __builtin_bit_cast(float, __builtin_amdgcn_update_dpp(0, __builtin_bit_cast(int, v), 0x140, 0xF, 0xF, true));
    const int iv = __builtin_bit_cast(int, v);
    return (__builtin_bit_cast(float, __builtin_amdgcn_readlane(iv, 0)) + __builtin_bit_cast(float, __builtin_amdgcn_readlane(iv, 16))) +
           (__builtin_bit_cast(float, __builtin_amdgcn_readlane(iv, 32)) + __builtin_bit_cast(float, __builtin_amdgcn_readlane(iv, 48)));
}
#define PIN8(r) asm volatile("" : "+v"((r)[0]), "+v"((r)[1]), "+v"((r)[2]), "+v"((r)[3]), "+v"((r)[4]), "+v"((r)[5]), "+v"((r)[6]), "+v"((r)[7]) :: "memory")
#define LDS_WAIT() asm volatile("s_waitcnt lgkmcnt(0)" ::: "memory")
#define VM_WAIT() asm volatile("s_waitcnt vmcnt(0)" ::: "memory")

#define XB_TMO      128
#define XB_XCNT(j)  (256  + 64 * (j))
#define XB_XSUB(j)  (1280 + 64 * (j))
#define XB_XGEN(j)  (2304 + 64 * (j))
#define XB_TOP      3328
#define XB_TOPGEN   3392
#define XCD_BAR_WORDS 3456
#define XB_SPIN_CAP (1u << 18)
__device__ __forceinline__ unsigned xb_ld(unsigned* p)              { return __hip_atomic_load(p, __ATOMIC_RELAXED, __HIP_MEMORY_SCOPE_AGENT); }
__device__ __forceinline__ unsigned xb_add(unsigned* p, unsigned v) { return __hip_atomic_fetch_add(p, v, __ATOMIC_RELAXED, __HIP_MEMORY_SCOPE_AGENT); }
__device__ __forceinline__ unsigned xb_xcc_id() { return (unsigned)__builtin_amdgcn_s_getreg((3 << 11) | 20) & 0xFu; }
#define XB_SPIN(cond, bar) do { unsigned _sp = 0; while (cond) { __builtin_amdgcn_s_sleep(1); \
    if ((++_sp & 255u) == 0u) { if (xb_ld(&(bar)[XB_TMO])) break; if (_sp > XB_SPIN_CAP) { atomicAdd(&(bar)[XB_TMO], 1u); break; } } } } while (0)
struct XcdBarrier { unsigned* bar; unsigned x; volatile LAS unsigned* st; bool lead; };
__device__ __forceinline__ int hw_lane() { int l; asm volatile("v_mbcnt_lo_u32_b32 %0, -1, 0\n\tv_mbcnt_hi_u32_b32 %0, -1, %0" : "=v"(l)); return l; }
__device__ __forceinline__ XcdBarrier xcd_barrier_post(unsigned* bar, volatile LAS unsigned* st) {
    XcdBarrier b; b.bar = bar; b.x = xb_xcc_id(); b.st = st; b.lead = threadIdx.x == 0;
    if (threadIdx.x == 0) (void)xb_add(&bar[XB_XCNT(b.x)], 1u);
    return b;
}
__device__ __forceinline__ void xcd_barrier_complete(unsigned* bar, unsigned x, unsigned& nloc, unsigned& nx) {
    const unsigned G = gridDim.x * gridDim.y * gridDim.z;
    unsigned sum, cnt, mine, sp = 0u;
    for (;;) {
        sum = 0u; cnt = 0u; mine = 0u;
#pragma unroll
        for (unsigned j = 0; j < 16; ++j) { const unsigned c = xb_ld(&bar[XB_XCNT(j)]); sum += c; cnt += (c > 0u) ? 1u : 0u; mine = (j == x) ? c : mine; }
        if (sum == G) break;
        __builtin_amdgcn_s_sleep(1);
        if ((++sp & 255u) == 0u) { if (xb_ld(&bar[XB_TMO])) break; if (sp > XB_SPIN_CAP) { atomicAdd(&bar[XB_TMO], 1u); break; } }
    }
    nloc = mine > 0u ? mine : 1u; nx = cnt > 0u ? cnt : 1u;
}
__device__ __forceinline__ void xcd_barrier(const XcdBarrier& b) {
    asm volatile("s_waitcnt vmcnt(0)" ::: "memory");
    __syncthreads();
    if (b.lead) {
        unsigned* bar = b.bar;
        __builtin_amdgcn_s_waitcnt(0);
        unsigned nloc = b.st[0], nx = b.st[1];
        if (nloc == 0u) { xcd_barrier_complete(bar, b.x, nloc, nx); b.st[0] = nloc; b.st[1] = nx; }
        const unsigned old = xb_add(&bar[XB_XSUB(b.x)], 1u);
        const unsigned gen = old / nloc;
        if (old + 1u == (gen + 1u) * nloc) {
            __builtin_amdgcn_fence(__ATOMIC_RELEASE, "agent");
            asm volatile("s_waitcnt vmcnt(0)" ::: "memory");
            const unsigned og = xb_add(&bar[XB_TOP], 1u);
            const unsigned tg = og / nx;
            if (og + 1u == (tg + 1u) * nx) xb_add(&bar[XB_TOPGEN], 1u);
            else XB_SPIN(xb_ld(&bar[XB_TOPGEN]) == tg, bar);
            __builtin_amdgcn_fence(__ATOMIC_ACQUIRE, "agent");
            xb_add(&bar[XB_XGEN(b.x)], 1u);
            asm volatile("s_waitcnt vmcnt(0)" ::: "memory");
        } else {
            XB_SPIN(xb_ld(&bar[XB_XGEN(b.x)]) == gen, bar);
            __builtin_amdgcn_fence(__ATOMIC_ACQUIRE, "agent");
            asm volatile("s_waitcnt vmcnt(0)" ::: "memory");
        }
    }
    __syncthreads();
}

namespace pg8 {
constexpr int BM = 256, BK = 64, HALF = 128, HTB = HALF * BK * 2, STAGE_BYTES = 8 * HTB, NXCD = 8, WGM = 4, WGM_UP = 8, WGM_DN = 4;
__host__ __device__ __forceinline__ int lds_byte(int r, int c) { const int st = (r >> 4) * 2 + (c >> 5), rr = r & 15, cc = c & 31, ob = rr * 64 + cc * 2; return st * 1024 + (ob ^ (((ob >> 9) & 1) << 5)); }
__host__ __device__ __forceinline__ void stage_rc(int b, int& R, int& C) { const int st = b / 1024, sb = b % 1024, swz = sb ^ (((sb >> 9) & 1) << 5); R = (st >> 1) * 16 + swz / 64; C = (st & 1) * 32 + (swz % 64) / 2; }
__host__ __device__ __forceinline__ int perm32(int rho) { const int n = rho >> 4, i = rho & 15; return 8 * (i >> 2) + 4 * n + (i & 3); }
struct Unit { int pm, pn; };
struct Gemm { const bf16_t* A; const bf16_t* Bt; int M, N, K, ld; };
struct StaticOrder {
    int nM, nN, nwg, G, c, wgm;
    __host__ __device__ void init(int M, int N, int G_, int c_, int wgm_ = WGM) { nM = M / BM; nN = N / BM; nwg = nM * nN; G = G_; c = c_; wgm = wgm_; }
    __host__ __device__ bool next(int i, Unit& u) const {
        const long L = (long)i * G + c; if (L >= nwg) return false;
        int wgid = (int)L; { const int q = nwg / NXCD, r = nwg % NXCD, xcd = wgid % NXCD, off = wgid / NXCD; wgid = (xcd < r ? xcd * (q + 1) : r * (q + 1) + (xcd - r) * q) + off; }
        const int nig = wgm * nN, gid = wgid / nig, fm = gid * wgm, gsz = (nM - fm) < wgm ? (nM - fm) : wgm;
        u.pm = fm + ((wgid % nig) % gsz); u.pn = (wgid % nig) / gsz; return true;
    }
    __device__ __forceinline__ void a_ready(const Unit&) const {}
    __device__ __forceinline__ void done(const Unit&) const {}
};

template <int ACT  , bool SPLIT8 = false  > struct EpiBf16 {
    static constexpr bool PERM = true, AFTER_DRAIN = false;
    bf16_t* O; int ldc; int split_cols; size_t split_stride; const unsigned long long* SS; float osc; unsigned char* O8; const unsigned long long* SSq;
    __device__ __forceinline__ void operator()(const f32x4 (&acc)[2][2][4][2], const Unit& u, int wr, int wc, int fr, int fq) const {
        const int row0 = u.pm * BM + wr * 64 + fr; int colt = u.pn * BM; bf16_t* base = O;
        if (split_cols) { const int t = colt / split_cols; base += (size_t)t * split_stride; colt -= t * split_cols; }
        const int col0 = colt + wc * 32 + 8 * fq;
        float rsv[8];
#pragma unroll
        for (int r = 0; r < 8; ++r) { const int row = row0 + (r >> 2) * HALF + (r & 3) * 16; float v = osc; if (SS) v *= ss_rstd(SS[row]); if (SSq) v *= ss_rms(SSq[row]); rsv[r] = v; }
        PIN8(rsv);
#pragma unroll
        for (int ai = 0; ai < 2; ++ai)
#pragma unroll
            for (int m = 0; m < 4; ++m) { bf16_t* rowp = base + (size_t)(row0 + ai * HALF + m * 16) * ldc + col0;
                const float rs = rsv[ai * 4 + m];
#pragma unroll
                for (int bj = 0; bj < 2; ++bj) { f32x4 v0 = acc[ai][bj][m][0] * rs, v1 = acc[ai][bj][m][1] * rs;
                    if (ACT == 1) {
#pragma unroll
                        for (int j = 0; j < 4; ++j) { const float a = fmaxf(v0[j], 0.f), b = fmaxf(v1[j], 0.f); v0[j] = a * a; v1[j] = b * b; } }
                    u32x4 w; w.x = cvt_pk_bf16(v0[0], v0[1]); w.y = cvt_pk_bf16(v0[2], v0[3]); w.z = cvt_pk_bf16(v1[0], v1[1]); w.w = cvt_pk_bf16(v1[2], v1[3]);
                    if (SPLIT8 && u.pn >= 32) { u32x2 q; q.x = cvt_pk_fp8(v0[0] * 2.f, v0[1] * 2.f, v0[2] * 2.f, v0[3] * 2.f); q.y = cvt_pk_fp8(v1[0] * 2.f, v1[1] * 2.f, v1[2] * 2.f, v1[3] * 2.f);
                        __builtin_nontemporal_store(q, (u32x2*)(O8 + (size_t)(row0 + ai * HALF + m * 16) * 8192 + (u.pn - 32) * BM + wc * 32 + 8 * fq + bj * HALF)); }
                    else if (ACT == 1) __builtin_nontemporal_store(w, (u32x4*)(rowp + bj * HALF));
                    else *(u32x4*)(rowp + bj * HALF) = w; } }
    }
};
struct EpiHidI8 {
    static constexpr bool PERM = true, AFTER_DRAIN = false;
    unsigned char* O; int ldc; const unsigned long long* SS; float osc; const unsigned long long* SSq; float ainv;
    __device__ __forceinline__ void operator()(const f32x4 (&acc)[2][2][4][2], const Unit& u, int wr, int wc, int fr, int fq) const {
        const int row0 = u.pm * BM + wr * 64 + fr, col0 = u.pn * BM + wc * 32 + 8 * fq;
        float rsv[8];
#pragma unroll
        for (int r = 0; r < 8; ++r) { const int row = row0 + (r >> 2) * HALF + (r & 3) * 16; rsv[r] = ss_rstd(SS[row]) * osc * ss_rms(SSq[row]); }
        PIN8(rsv);
#pragma unroll
        for (int ai = 0; ai < 2; ++ai)
#pragma unroll
            for (int m = 0; m < 4; ++m) { const int row = row0 + ai * HALF + m * 16; unsigned char* rowp = O + (size_t)row * ldc + col0;
                const float rs = rsv[ai * 4 + m];
#pragma unroll
                for (int bj = 0; bj < 2; ++bj) { unsigned w[2];
#pragma unroll
                    for (int n = 0; n < 2; ++n) { unsigned q[4];
#pragma unroll
                        for (int j = 0; j < 4; ++j) { const float a = acc[ai][bj][m][n][j] * rs;
                            q[j] = __float_as_uint(__builtin_amdgcn_fmed3f(__builtin_fmaf(a, __builtin_fabsf(a), 8388608.f), 8388608.f, 8388608.f + 255.f)); }
                        w[n] = (__builtin_amdgcn_perm(q[1], q[0], 0x0c0c0400u) | __builtin_amdgcn_perm(q[3], q[2], 0x04000c0cu)) ^ 0x80808080u; }
                    u32x2 ww; ww.x = w[0]; ww.y = w[1]; *(u32x2*)(rowp + bj * HALF) = ww; } }
    }
};
template <bool BASE_F32, int QM = 0, bool NOSS = false, bool CSUM = false> struct EpiResB;
template <bool BASE_F32, int QM  , bool NOSS  , bool CSUM  > struct EpiResB {
    static constexpr bool PERM = true, AFTER_DRAIN = false;
    const float* basef; bf16_t* X; unsigned long long* SS; float osc; const unsigned long long* SSq; const int* CS; LAS float* red;
    __device__ __forceinline__ void operator()(const f32x4 (&acc)[2][2][4][2], const Unit& u, int wr, int wc, int fr, int fq) const {
        const int row0 = u.pm * BM + wr * 64 + fr, col0 = u.pn * BM + wc * 32 + 8 * fq;
        f32x4 cs0[2], cs1[2];
        if constexpr (CSUM) {
#pragma unroll
            for (int bj = 0; bj < 2; ++bj) { const v4i_t c0 = *(const v4i_t*)(CS + col0 + bj * HALF), c1 = *(const v4i_t*)(CS + col0 + bj * HALF + 4);
                cs0[bj] = (f32x4){128.f * (float)c0[0], 128.f * (float)c0[1], 128.f * (float)c0[2], 128.f * (float)c0[3]}; cs1[bj] = (f32x4){128.f * (float)c1[0], 128.f * (float)c1[1], 128.f * (float)c1[2], 128.f * (float)c1[3]}; } }
        float qiv[8];
        if constexpr (QM == 2) {
#pragma unroll
            for (int r = 0; r < 8; ++r) qiv[r] = QINV * ss_rstd(SSq[row0 + (r >> 2) * HALF + (r & 3) * 16]);
            PIN8(qiv); }
#pragma unroll
        for (int ai = 0; ai < 2; ++ai) {
            u32x4 bw[4][2]; f32x4 bf[BASE_F32 ? 4 : 1][2][2];
#pragma unroll
            for (int m = 0; m < 4; ++m)
#pragma unroll
                for (int bj = 0; bj < 2; ++bj) { const size_t o = (size_t)(row0 + ai * HALF + m * 16) * 4096 + col0 + bj * HALF;
                    if constexpr (BASE_F32) { bf[m][bj][0] = *(const f32x4*)(basef + o); bf[m][bj][1] = *(const f32x4*)(basef + o + 4); }
                    else bw[m][bj] = *(const u32x4*)(X + o); }
            if constexpr (BASE_F32) { asm volatile("" ::: "memory"); }
            else {
#pragma unroll
                for (int m = 0; m < 4; ++m) asm volatile("" : "+v"(bw[m][0]), "+v"(bw[m][1]) :: "memory"); }
#pragma unroll
            for (int m = 0; m < 4; ++m) { const int row = row0 + ai * HALF + m * 16; const size_t ro = (size_t)row * 4096 + col0; float ss = 0.f;
                float qi = 0.f; if constexpr (QM == 2) qi = qiv[ai * 4 + m];
#pragma unroll
                for (int bj = 0; bj < 2; ++bj) { const size_t o = ro + bj * HALF; f32x4 b0, b1;
                    if constexpr (BASE_F32) { b0 = bf[m][bj][0]; b1 = bf[m][bj][1]; }
                    else { const u32x4 w = bw[m][bj];
                        b0 = (f32x4){__uint_as_float(w.x << 16), __uint_as_float(w.x & 0xffff0000u), __uint_as_float(w.y << 16), __uint_as_float(w.y & 0xffff0000u)};
                        b1 = (f32x4){__uint_as_float(w.z << 16), __uint_as_float(w.z & 0xffff0000u), __uint_as_float(w.w << 16), __uint_as_float(w.w & 0xffff0000u)}; }
                    f32x4 a0 = acc[ai][bj][m][0], a1 = acc[ai][bj][m][1]; if constexpr (CSUM) { a0 = a0 + cs0[bj]; a1 = a1 + cs1[bj]; }
                    const f32x4 v0 = b0 + a0 * osc, v1 = b1 + a1 * osc;
                    ss += ((v0[0] * v0[0] + v0[1] * v0[1]) + (v0[2] * v0[2] + v0[3] * v0[3])) + ((v1[0] * v1[0] + v1[1] * v1[1]) + (v1[2] * v1[2] + v1[3] * v1[3]));
                    u32x4 w; w.x = cvt_pk_bf16(v0[0], v0[1]); w.y = cvt_pk_bf16(v0[2], v0[3]); w.z = cvt_pk_bf16(v1[0], v1[1]); w.w = cvt_pk_bf16(v1[2], v1[3]);
                    *(u32x4*)(X + o) = w;
                    if constexpr (QM == 1) { u32x2 q; q.x = cvt_pk_fp8(v0[0], v0[1], v0[2], v0[3]); q.y = cvt_pk_fp8(v1[0], v1[1], v1[2], v1[3]); *(u32x2*)((unsigned char*)X + X8_DELTA + o) = q; }
                    if constexpr (QM == 2) { u32x2 q; q.x = pk_i8(v0[0] * qi, v0[1] * qi, v0[2] * qi, v0[3] * qi); q.y = pk_i8(v1[0] * qi, v1[1] * qi, v1[2] * qi, v1[3] * qi); *(u32x2*)((unsigned char*)X + X8_DELTA + o) = q; } }
                { auto r16 = __builtin_amdgcn_permlane16_swap(__float_as_uint(ss), __float_as_uint(ss), false, false); ss = __uint_as_float(r16[0]) + __uint_as_float(r16[1]);
                  auto r32_ = __builtin_amdgcn_permlane32_swap(__float_as_uint(ss), __float_as_uint(ss), false, false); ss = __uint_as_float(r32_[0]) + __uint_as_float(r32_[1]); }
                if (!NOSS && fq == 0) red[wc * 256 + wr * 64 + fr + ai * HALF + m * 16] = ss; } }
        if constexpr (!NOSS) {
            LDS_WAIT(); __builtin_amdgcn_s_barrier();
            if (wr == 0) { const int rt = wc * 64 + fq * 16 + fr; const float t = (red[rt] + red[256 + rt]) + (red[512 + rt] + red[768 + rt]); atomicAdd(SS + u.pm * BM + rt, ss_fix(t)); } }
    }
};
struct EpiInA {
    static constexpr bool PERM = true, AFTER_DRAIN = false;
    bf16_t *Q, *Kb, *Vb, *QI, *KI; float* WI; const float* COS; const float* SIN; const unsigned long long* SS; int seg0; float osc;
    __device__ __forceinline__ void operator()(const f32x4 (&acc)[2][2][4][2], const Unit& u, int wr, int wc, int fr, int fq) const {
        const int row0 = u.pm * BM + wr * 64 + fr;
        const int g = wc * 4 + fq;
        float rr[8];
#pragma unroll
        for (int r = 0; r < 8; ++r) rr[r] = SS ? ss_rstd(SS[row0 + (r >> 2) * HALF + (r & 3) * 16]) : 1.0f;
        PIN8(rr);
        const int segA = seg0 + u.pn * 2;
        const bool rope0 = !(segA >= 40 && segA < 48) && segA < 81, rope1 = !(segA + 1 >= 40 && segA + 1 < 48) && segA + 1 < 81;
#pragma unroll
        for (int ah = 0; ah < 4; ++ah) { const int ai = ah >> 1, mh = (ah & 1) * 2;
            f32x4 cv[2], sv[2];
            if (rope0 || rope1) {
#pragma unroll
                for (int m = 0; m < 2; ++m) { const int pos = (row0 + ai * HALF + (mh + m) * 16) & (SEQ - 1); cv[m] = *(const f32x4*)(COS + pos * 64 + g * 4); sv[m] = *(const f32x4*)(SIN + pos * 64 + g * 4); }
#pragma unroll
                for (int m = 0; m < 2; ++m) asm volatile("" : "+v"(cv[m]), "+v"(sv[m]) :: "memory"); }
#pragma unroll
            for (int bj = 0; bj < 2; ++bj) {
                const int seg = segA + bj;
                bf16_t* dst; int ld; int mode;
                if (seg < 32)       { dst = Q  + seg * 128;        ld = 4096; mode = 0; }
                else if (seg < 40)  { dst = Kb + (seg - 32) * 128; ld = 1024; mode = 0; }
                else if (seg < 48)  { dst = Vb + (seg - 40) * 128; ld = 1024; mode = 1; }
                else if (seg < 80)  { dst = QI + (seg - 48) * 128; ld = 4096; mode = 0; }
                else if (seg == 80) { dst = KI;                    ld = 128;  mode = 0; }
                else                { dst = nullptr;               ld = 0;    mode = 2; }
                if (mode == 2) {
                    if (wc == 0) {
#pragma unroll
                        for (int m2 = 0; m2 < 2; ++m2) { const int m = mh + m2; float* p = WI + (size_t)(row0 + ai * HALF + m * 16) * 32 + fq * 8;
                            const float rs = 0.015625f * rr[ai * 4 + m];
                            *(f32x4*)p = acc[ai][bj][m][0] * rs; *(f32x4*)(p + 4) = acc[ai][bj][m][1] * rs; }
                    }
                } else {
#pragma unroll
                    for (int m2 = 0; m2 < 2; ++m2) { const int m = mh + m2; const int row = row0 + ai * HALF + m * 16;
                        const float rs = rr[ai * 4 + m] * osc;
                        f32x4 v0 = acc[ai][bj][m][0] * rs, v1 = acc[ai][bj][m][1] * rs;
                        if (mode == 0) { const f32x4 c4 = cv[m2], s4 = sv[m2];
                            const f32x4 y1 = v0 * c4 - v1 * s4, y2 = v1 * c4 + v0 * s4; v0 = y1; v1 = y2; }
                        u32x4 w; w.x = cvt_pk_bf16(v0[0], v0[1]); w.y = cvt_pk_bf16(v0[2], v0[3]); w.z = cvt_pk_bf16(v1[0], v1[1]); w.w = cvt_pk_bf16(v1[2], v1[3]);
                        *(u32x4*)(dst + (size_t)row * ld + g * 8) = w; }
                }
            }
        }
    }
};

__device__ __forceinline__ void mma8_f8(f32x4 (&a)[4][2], const v8i_t (&bt)[2], const v8i_t (&at)[4], unsigned sc) {
    asm volatile("v_mfma_scale_f32_16x16x128_f8f6f4 %0, %8, %10, %0, %14, %14 op_sel_hi:[0,0,0]\n\t"
                 "v_mfma_scale_f32_16x16x128_f8f6f4 %1, %9, %10, %1, %14, %14 op_sel_hi:[0,0,0]\n\t"
                 "v_mfma_scale_f32_16x16x128_f8f6f4 %2, %8, %11, %2, %14, %14 op_sel_hi:[0,0,0]\n\t"
                 "v_mfma_scale_f32_16x16x128_f8f6f4 %3, %9, %11, %3, %14, %14 op_sel_hi:[0,0,0]\n\t"
                 "v_mfma_scale_f32_16x16x128_f8f6f4 %4, %8, %12, %4, %14, %14 op_sel_hi:[0,0,0]\n\t"
                 "v_mfma_scale_f32_16x16x128_f8f6f4 %5, %9, %12, %5, %14, %14 op_sel_hi:[0,0,0]\n\t"
                 "v_mfma_scale_f32_16x16x128_f8f6f4 %6, %8, %13, %6, %14, %14 op_sel_hi:[0,0,0]\n\t"
                 "v_mfma_scale_f32_16x16x128_f8f6f4 %7, %9, %13, %7, %14, %14 op_sel_hi:[0,0,0]"
                 : "+v"(a[0][0]), "+v"(a[0][1]), "+v"(a[1][0]), "+v"(a[1][1]), "+v"(a[2][0]), "+v"(a[2][1]), "+v"(a[3][0]), "+v"(a[3][1])
                 : "v"(bt[0]), "v"(bt[1]), "v"(at[0]), "v"(at[1]), "v"(at[2]), "v"(at[3]), "v"(sc));
}
template <class Epi, class Sched, bool ALIGN_EPI = false, bool SP2 = false, int PREC = 0>
__device__ __forceinline__ void gemm_phase(LAS unsigned char* lds, const Gemm g, const Sched& S, const Epi& E, const int tid) {
    const int wid = __builtin_amdgcn_readfirstlane(tid >> 6), lane = tid & 63, wr = wid >> 2, wc = wid & 3, fr = lane & 15, fq = lane >> 4;
    constexpr bool F8 = (PREC == 1), I8 = (PREC == 2);
    const int K = g.K, LDE = g.ld ? g.ld : K, RB = PREC ? LDE : 2 * LDE  , nt = (PREC ? K : 2 * K) / 128;
    unsigned voffA[2], voffB[2];
#pragma unroll
    for (int i = 0; i < 2; ++i) { int R, C; stage_rc(tid * 16 + i * 8192, R, C); const int Rb = Epi::PERM ? ((R & ~31) + perm32(R & 31)) : R;
        voffA[i] = (unsigned)(R * RB + 2 * C); voffB[i] = (unsigned)(Rb * RB + 2 * C); }
    const size_t kstep = (size_t)(BK * 2);
    const size_t hstep = (size_t)HALF * RB;
    const size_t tstep = 2 * hstep;
    const unsigned ldsw = (unsigned)wid * 1024u;
    const int aoff = F8 ? lds_byte(wr * 64 + fr, fq * 16) : lds_byte(wr * 64 + fr, fq * 8), boff = F8 ? lds_byte(wc * 32 + fr, fq * 16) : lds_byte(wc * 32 + fr, fq * 8);
    constexpr int KOFF = F8 ? 16 : 1024;
#define PG8_SA(b, h) (((b) * 2 + (h)) * HTB)
#define PG8_SB(b, h) ((4 + (b) * 2 + (h)) * HTB)
#define PG8_STAGE(bufoff, gbase, voff) do { _Pragma("unroll") for (int _i = 0; _i < 2; ++_i) \
        __builtin_amdgcn_global_load_lds((const unsigned*)((const char*)(gbase) + (voff)[_i]), (LAS unsigned*)(lds + (bufoff) + ldsw + _i * 8192), 16, 0, 0); } while (0)
#define PG8_LDA(dst, b, h) do { _Pragma("unroll") for (int m = 0; m < 4; ++m) _Pragma("unroll") for (int k = 0; k < 2; ++k) dst[m][k] = *(const LAS bf16x8*)(lds + PG8_SA(b, h) + aoff + m * 2048 + k * KOFF); } while (0)
#define PG8_LDB(dst, b, h) do { _Pragma("unroll") for (int n = 0; n < 2; ++n) _Pragma("unroll") for (int k = 0; k < 2; ++k) dst[n][k] = *(const LAS bf16x8*)(lds + PG8_SB(b, h) + boff + n * 2048 + k * KOFF); } while (0)
#define PG8_CAT(x) __builtin_shufflevector(__builtin_bit_cast(v4i_t, (x)[0]), __builtin_bit_cast(v4i_t, (x)[1]), 0, 1, 2, 3, 4, 5, 6, 7)
#define PG8_MMA(ai, bj, At, Bt) do { __builtin_amdgcn_s_setprio(1); _Pragma("unroll") for (int m = 0; m < 4; ++m) _Pragma("unroll") for (int n = 0; n < 2; ++n) { \
        if constexpr (PREC == 0) { _Pragma("unroll") for (int k = 0; k < 2; ++k) acc[ai][bj][m][n] = __builtin_amdgcn_mfma_f32_16x16x32_bf16(Bt[n][k], At[m][k], acc[ai][bj][m][n], 0, 0, 0); } \
        if constexpr (I8) { _Pragma("unroll") for (int k = 0; k < 2; ++k) acc[ai][bj][m][n] = __builtin_bit_cast(f32x4, __builtin_amdgcn_mfma_i32_16x16x64_i8(__builtin_bit_cast(v4i_t, Bt[n][k]), __builtin_bit_cast(v4i_t, At[m][k]), __builtin_bit_cast(v4i_t, acc[ai][bj][m][n]), 0, 0, 0)); } } \
        if constexpr (F8) { const v8i_t bt_[2] = {PG8_CAT(Bt[0]), PG8_CAT(Bt[1])}; const v8i_t at_[4] = {PG8_CAT(At[0]), PG8_CAT(At[1]), PG8_CAT(At[2]), PG8_CAT(At[3])}; mma8_f8(acc[ai][bj], bt_, at_, f8scale); } \
        __builtin_amdgcn_s_setprio(0); } while (0)
#define PG8_WAIT_V(n) asm volatile("s_waitcnt vmcnt(" #n ")" ::: "memory")
#define PG8_WAIT_L(n) asm volatile("s_waitcnt lgkmcnt(" #n ")" ::: "memory")
#define PG8_BAR __builtin_amdgcn_s_barrier()
#define PG8_SCHED __builtin_amdgcn_sched_barrier(0)
    Unit cur, nxt; int ui = 0;
    if (!S.next(0, cur)) return;
    f32x4 acc[2][2][4][2];
#pragma unroll
    for (int a = 0; a < 2; ++a)
#pragma unroll
        for (int b = 0; b < 2; ++b)
#pragma unroll
            for (int m = 0; m < 4; ++m)
#pragma unroll
                for (int n = 0; n < 2; ++n) acc[a][b][m][n] = (f32x4){0.f, 0.f, 0.f, 0.f};
    bf16x8 At[4][2], B0[2][2], B1[2][2];
    unsigned f8scale = 0x7F7F7F7Fu; asm volatile("" : "+v"(f8scale));
    const char* cA = (const char*)g.A + (size_t)cur.pm * tstep; const char* cB = (const char*)g.Bt + (size_t)cur.pn * tstep;
    S.a_ready(cur);
    if constexpr (SP2) {
        PG8_STAGE(PG8_SB(0, 0), cB, voffB); PG8_STAGE(PG8_SB(0, 1), cB + hstep, voffB); PG8_STAGE(PG8_SA(0, 0), cA, voffA); PG8_STAGE(PG8_SA(0, 1), cA + hstep, voffA);
        if (wr == 1) PG8_BAR;
        PG8_WAIT_V(2); PG8_BAR;
        PG8_STAGE(PG8_SB(1, 0), cB + kstep, voffB); PG8_STAGE(PG8_SA(1, 0), cA + kstep, voffA); PG8_STAGE(PG8_SB(1, 1), cB + hstep + kstep, voffB);
        PG8_WAIT_V(6); PG8_BAR;
    } else {
        PG8_STAGE(PG8_SB(0, 0), cB, voffB); PG8_STAGE(PG8_SA(0, 0), cA, voffA); PG8_STAGE(PG8_SB(0, 1), cB + hstep, voffB); PG8_STAGE(PG8_SA(0, 1), cA + hstep, voffA);
        if (wr == 1) PG8_BAR;
        PG8_WAIT_V(4); PG8_BAR;
        PG8_STAGE(PG8_SB(1, 0), cB + kstep, voffB); PG8_STAGE(PG8_SA(1, 0), cA + kstep, voffA); PG8_STAGE(PG8_SB(1, 1), cB + hstep + kstep, voffB);
        PG8_WAIT_V(6); PG8_BAR;
    }
    for (;;) {
        const bool has_next = S.next(ui + 1, nxt);
        const char* nA = has_next ? (const char*)g.A + (size_t)nxt.pm * tstep : cA; const char* nB = has_next ? (const char*)g.Bt + (size_t)nxt.pn * tstep : cB;
        for (int t = 0; t < nt; t += 2) {
            const bool last = (t == nt - 2);
            const char* a1 = cA + (size_t)(t + 1) * kstep;
            const char* a2 = last ? nA : cA + (size_t)(t + 2) * kstep; const char* b2 = last ? nB : cB + (size_t)(t + 2) * kstep;
            const char* a3 = a2 + kstep; const char* b3 = b2 + kstep;
            if (last && has_next) S.a_ready(nxt);
            if constexpr (SP2) {
            PG8_LDB(B0, 0, 0); PG8_LDB(B1, 0, 1); PG8_SCHED; PG8_LDA(At, 0, 0); PG8_STAGE(PG8_SA(1, 1), a1 + hstep, voffA);
            PG8_WAIT_V(8); PG8_WAIT_L(0); PG8_BAR; PG8_MMA(0, 0, At, B0); PG8_MMA(0, 1, At, B1); PG8_BAR; PG8_SCHED;
            PG8_LDA(At, 0, 1); PG8_STAGE(PG8_SB(0, 0), b2, voffB); PG8_STAGE(PG8_SB(0, 1), b2 + hstep, voffB); PG8_STAGE(PG8_SA(0, 0), a2, voffA);
            PG8_WAIT_V(8); PG8_WAIT_L(0); PG8_BAR; PG8_MMA(1, 0, At, B0); PG8_MMA(1, 1, At, B1); PG8_BAR; PG8_SCHED;
            PG8_LDB(B0, 1, 0); PG8_LDB(B1, 1, 1); PG8_SCHED; PG8_LDA(At, 1, 0); PG8_STAGE(PG8_SA(0, 1), a2 + hstep, voffA);
            PG8_WAIT_V(8); PG8_WAIT_L(0); PG8_BAR; PG8_MMA(0, 0, At, B0); PG8_MMA(0, 1, At, B1); PG8_BAR; PG8_SCHED;
            PG8_LDA(At, 1, 1); PG8_STAGE(PG8_SB(1, 0), b3, voffB); PG8_STAGE(PG8_SB(1, 1), b3 + hstep, voffB); PG8_STAGE(PG8_SA(1, 0), a3, voffA);
            PG8_WAIT_V(8); PG8_WAIT_L(0); PG8_BAR; PG8_MMA(1, 0, At, B0); PG8_MMA(1, 1, At, B1); PG8_BAR; PG8_SCHED;
            } else {
            PG8_LDB(B0, 0, 0); PG8_SCHED; PG8_LDA(At, 0, 0); PG8_STAGE(PG8_SA(1, 1), a1 + hstep, voffA);
            PG8_WAIT_L(8); PG8_BAR; PG8_WAIT_L(0); PG8_MMA(0, 0, At, B0); PG8_BAR; PG8_SCHED;
            PG8_LDB(B1, 0, 1); PG8_STAGE(PG8_SB(0, 0), b2, voffB);
            PG8_BAR; PG8_WAIT_L(0); PG8_MMA(0, 1, At, B1); PG8_BAR;
            PG8_LDA(At, 0, 1); PG8_STAGE(PG8_SA(0, 0), a2, voffA);
            PG8_BAR; PG8_WAIT_L(0); PG8_MMA(1, 0, At, B0); PG8_BAR; PG8_SCHED;
            PG8_STAGE(PG8_SB(0, 1), b2 + hstep, voffB);
            PG8_WAIT_V(6); PG8_BAR; PG8_MMA(1, 1, At, B1); PG8_BAR;
            PG8_LDB(B0, 1, 0); PG8_SCHED; PG8_LDA(At, 1, 0); PG8_STAGE(PG8_SA(0, 1), a2 + hstep, voffA);
            PG8_WAIT_L(8); PG8_BAR; PG8_WAIT_L(0); PG8_MMA(0, 0, At, B0); PG8_BAR; PG8_SCHED;
            PG8_LDB(B1, 1, 1); PG8_STAGE(PG8_SB(1, 0), b3, voffB);
            PG8_BAR; PG8_WAIT_L(0); PG8_MMA(0, 1, At, B1); PG8_BAR;
            PG8_LDA(At, 1, 1); PG8_STAGE(PG8_SA(1, 0), a3, voffA);
            PG8_BAR; PG8_WAIT_L(0); PG8_MMA(1, 0, At, B0); PG8_BAR; PG8_SCHED;
            PG8_STAGE(PG8_SB(1, 1), b3 + hstep, voffB);
            PG8_WAIT_V(6); PG8_BAR; PG8_MMA(1, 1, At, B1); PG8_BAR;
            }
        }
        if constexpr (ALIGN_EPI) { if (wr == 0) PG8_BAR; }
        if constexpr (F8) asm volatile("s_nop 15\n\ts_nop 15" ::: "memory");
        if constexpr (I8) {
#pragma unroll
            for (int a = 0; a < 2; ++a)
#pragma unroll
                for (int b = 0; b < 2; ++b)
#pragma unroll
                    for (int m = 0; m < 4; ++m)
#pragma unroll
                        for (int n = 0; n < 2; ++n) { const v4i_t iv = __builtin_bit_cast(v4i_t, acc[a][b][m][n]); acc[a][b][m][n] = (f32x4){(float)iv[0], (float)iv[1], (float)iv[2], (float)iv[3]}; } }
        if constexpr (!Epi::AFTER_DRAIN) { E(acc, cur, wr, wc, fr, fq); S.done(cur); }
        if (!has_next) break;
#pragma unroll
        for (int a = 0; a < 2; ++a)
#pragma unroll
            for (int b = 0; b < 2; ++b)
#pragma unroll
                for (int m = 0; m < 4; ++m)
#pragma unroll
                    for (int n = 0; n < 2; ++n) acc[a][b][m][n] = (f32x4){0.f, 0.f, 0.f, 0.f};
        cur = nxt; cA = nA; cB = nB; ++ui;
        if constexpr (ALIGN_EPI) { if (wr == 1) PG8_BAR; }
    }
    PG8_WAIT_V(0);
    if constexpr (!ALIGN_EPI) { if (wr == 0) PG8_BAR; }
    PG8_BAR;
#undef PG8_SA
#undef PG8_SB
#undef PG8_STAGE
#undef PG8_LDA
#undef PG8_LDB
#undef PG8_MMA
#undef PG8_CAT
#undef PG8_WAIT_V
#undef PG8_WAIT_L
#undef PG8_BAR
#undef PG8_SCHED
}
}

namespace att {
constexpr int D = 128, NW = 8, QBLK = 32, KVBLK = 64;
constexpr float SCALE = 0.088388347648318440f;
constexpr float THR = 8.f;
constexpr int SHM_V = KVBLK * D * 2, SHM_K = KVBLK * D * 2;
constexpr int OFF_WS = 2 * SHM_V + 2 * SHM_K;
constexpr int OFF_BT = OFF_WS + NW * 64 * 4;
constexpr int OFF_Q = OFF_BT + 4096;
constexpr int SHM_ATTN = OFF_Q + NW * 8704;
static_assert(SHM_ATTN <= MISC_OFF, "attention LDS map");
#define KSWZ(row, colB) ((row) * 256 + ((colB) ^ (((row) & 7) << 4)))
#define SBAR() __builtin_amdgcn_sched_barrier(0)
#define MBIT(r) (((r) & 3) + 8 * ((r) >> 2))
__device__ __forceinline__ int crow(int r, int hi) { return (r & 3) + 8 * (r >> 2) + 4 * hi; }
__device__ __forceinline__ unsigned cvtpk(float lo, float hi) { unsigned r; asm volatile("v_cvt_pk_bf16_f32 %0, %1, %2" : "=v"(r) : "v"(lo), "v"(hi)); return r; }

template <int MODE>
__device__ __forceinline__ void partialSM(f32x16& p0, f32x16& p1, float& m_reg, float& mn, float& alpha, const LAS float* bt) {
    constexpr float C = SCALE * 1.4426950408889634f;
    float pmax = p0[0];
#pragma unroll
    for (int r = 1; r < 16; ++r) pmax = fmaxf(pmax, p0[r]);
#pragma unroll
    for (int r = 0; r < 16; ++r) pmax = fmaxf(pmax, p1[r]);
    { auto rr = __builtin_amdgcn_permlane32_swap(__float_as_uint(pmax), __float_as_uint(pmax), false, false);
      pmax = fmaxf(__uint_as_float(rr[0]), __uint_as_float(rr[1])); }
    if (__builtin_expect(__all(pmax - m_reg <= THR / SCALE), 1)) { mn = m_reg; alpha = 1.f; }
    else { mn = fmaxf(m_reg, pmax); alpha = __builtin_amdgcn_exp2f((m_reg - mn) * C); m_reg = mn; }
    const float mnC = -mn * C;
    if (MODE == 1) {
#pragma unroll
        for (int r = 0; r < 16; ++r) p0[r] = fmaf(p0[r], C, mnC) + bt[MBIT(r)];
#pragma unroll
        for (int r = 0; r < 16; ++r) p1[r] = fmaf(p1[r], C, mnC) + bt[32 + MBIT(r)];
    } else {
#pragma unroll
        for (int r = 0; r < 16; ++r) p0[r] = fmaf(p0[r], C, mnC);
#pragma unroll
        for (int r = 0; r < 16; ++r) p1[r] = fmaf(p1[r], C, mnC);
    }
#pragma unroll
    for (int r = 0; r < 16; ++r) p0[r] = __builtin_amdgcn_exp2f(p0[r]);
}
template <int MODE>
__device__ __forceinline__ void finishSM(f32x16& p0, f32x16& p1, float alpha, float& l_reg, bf16x8& pa0, bf16x8& pa1, bf16x8& pa2, bf16x8& pa3, unsigned mlo, unsigned mhi) {
#pragma unroll
    for (int r = 0; r < 16; ++r) p1[r] = __builtin_amdgcn_exp2f(p1[r]);
    if (MODE == 0) {
#pragma unroll
        for (int r = 0; r < 16; ++r) { p0[r] = __uint_as_float(__float_as_uint(p0[r]) & (unsigned)__builtin_amdgcn_sbfe((int)mlo, MBIT(r), 1));
                                       p1[r] = __uint_as_float(__float_as_uint(p1[r]) & (unsigned)__builtin_amdgcn_sbfe((int)mhi, MBIT(r), 1)); }
    }
    float ps = 0;
#pragma unroll
    for (int r = 0; r < 16; ++r) ps += p0[r];
#pragma unroll
    for (int r = 0; r < 16; ++r) ps += p1[r];
    { auto rr = __builtin_amdgcn_permlane32_swap(__float_as_uint(ps), __float_as_uint(ps), false, false);
      ps = __uint_as_float(rr[0]) + __uint_as_float(rr[1]); }
    l_reg = l_reg * alpha + ps;
#define PK4(P, BASE, OUT) do { unsigned a0 = cvtpk(P[BASE + 0], P[BASE + 1]), a1 = cvtpk(P[BASE + 2], P[BASE + 3]);   \
    unsigned b0 = cvtpk(P[BASE + 4], P[BASE + 5]), b1 = cvtpk(P[BASE + 6], P[BASE + 7]);                              \
    auto r0 = __builtin_amdgcn_permlane32_swap(a0, b0, false, false); auto r1 = __builtin_amdgcn_permlane32_swap(a1, b1, false, false); \
    u32x4 w = {r0[0], r1[0], r0[1], r1[1]}; OUT = *reinterpret_cast<bf16x8*>(&w); } while (0)
    PK4(p0, 0, pa0); PK4(p0, 8, pa1); PK4(p1, 0, pa2); PK4(p1, 8, pa3);
#undef PK4
}
__device__ __forceinline__ void qkt(f32x16& p0, f32x16& p1, const LAS char* Ks, const LAS char* qb, int r32, int hi) {
    asm volatile("" : "+v"(r32));
    p0 = f32x16{}; p1 = f32x16{};
#pragma unroll
    for (int d0 = 0; d0 < 8; ++d0) { const int cb = (d0 * 16 + hi * 8) * 2;
        const bf16x8 b0 = *reinterpret_cast<const LAS bf16x8*>(Ks + KSWZ(r32, cb));
        const bf16x8 b1 = *reinterpret_cast<const LAS bf16x8*>(Ks + KSWZ(32 + r32, cb));
        const bf16x8 q = *reinterpret_cast<const LAS bf16x8*>(qb + d0 * 32);
        p0 = __builtin_amdgcn_mfma_f32_32x32x16_bf16(b0, q, p0, 0, 0, 0);
        p1 = __builtin_amdgcn_mfma_f32_32x32x16_bf16(b1, q, p1, 0, 0, 0); }
}
__device__ __forceinline__ int v_st(int k, int c) { const int kk = (k & ~0xC) | ((k & 4) << 1) | ((k & 8) >> 1); return ((kk >> 3) * 4 + (c >> 5)) * 512 + ((kk & 7) * 32 + (c & 31)) * 2; }
__device__ __forceinline__ int v_rd_base(int lane) { return ((lane & 3) << 3) | (((lane >> 2) & 3) << 6) | (((lane >> 4) & 1) << 5) | (((lane >> 5) & 1) << 8); }
constexpr int v_rd_off(int d0, int ks, int half) { return d0 * 512 + ks * 4096 + half * 2048; }
template <int OFF> __device__ __forceinline__ s16x4 tr_read(int vb) {
    s16x4 r; asm volatile("ds_read_b64_tr_b16 %0, %1 offset:%2" : "=&v"(r) : "v"(vb), "i"(OFF) : "memory"); return r;
}
template <int D0> __device__ __forceinline__ void pv_one(f32x16& od, int vb, bf16x8 pa0, bf16x8 pa1, bf16x8 pa2, bf16x8 pa3) {
    const s16x4 l0 = tr_read<v_rd_off(D0, 0, 0)>(vb), h0 = tr_read<v_rd_off(D0, 0, 1)>(vb), l1 = tr_read<v_rd_off(D0, 1, 0)>(vb), h1 = tr_read<v_rd_off(D0, 1, 1)>(vb);
    const s16x4 l2 = tr_read<v_rd_off(D0, 2, 0)>(vb), h2 = tr_read<v_rd_off(D0, 2, 1)>(vb), l3 = tr_read<v_rd_off(D0, 3, 0)>(vb), h3 = tr_read<v_rd_off(D0, 3, 1)>(vb);
    asm volatile("s_waitcnt lgkmcnt(0)" ::: "memory"); SBAR();
#define PK(L, H) (bf16x8){L[0], L[1], L[2], L[3], H[0], H[1], H[2], H[3]}
    od = __builtin_amdgcn_mfma_f32_32x32x16_bf16(pa0, PK(l0, h0), od, 0, 0, 0);
    od = __builtin_amdgcn_mfma_f32_32x32x16_bf16(pa1, PK(l1, h1), od, 0, 0, 0);
    od = __builtin_amdgcn_mfma_f32_32x32x16_bf16(pa2, PK(l2, h2), od, 0, 0, 0);
    od = __builtin_amdgcn_mfma_f32_32x32x16_bf16(pa3, PK(l3, h3), od, 0, 0, 0);
#undef PK
}
__device__ __forceinline__ void pv_d0(f32x16* o, int vb, bf16x8 pa0, bf16x8 pa1, bf16x8 pa2, bf16x8 pa3) {
    pv_one<0>(o[0], vb, pa0, pa1, pa2, pa3); pv_one<1>(o[1], vb, pa0, pa1, pa2, pa3); pv_one<2>(o[2], vb, pa0, pa1, pa2, pa3); pv_one<3>(o[3], vb, pa0, pa1, pa2, pa3);
}

template <int MODE, int LDQ, int LDK, int LDO, bool OF8 = false>
__device__ __forceinline__ void attn_body(const bf16_t* __restrict__ Qw, const bf16_t* __restrict__ Kh, const bf16_t* __restrict__ Vh, bf16_t* __restrict__ Ow,
                                          int NT, int nvalid, const unsigned long long* __restrict__ mcol, int jlo, int jhi, int bb0, LAS char* lds, const int tid) {
    const int wid = tid >> 6, lane = tid & 63, r32 = lane & 31, hi = lane >> 5;
    LAS char* V_lds = lds; LAS char* K_lds = lds + 2 * SHM_V;
    LAS float* ws = (LAS float*)(lds + OFF_WS) + wid * 64; LAS float* li_l = ws; LAS float* al_l = ws + 32;
    const LAS float* btab = (const LAS float*)(lds + OFF_BT);
    float m_reg = -1e30f, l_reg = 0; f32x16 o[4] = {};
    LAS char* qr = lds + OFF_Q + wid * 8704 + r32 * 272 + hi * 16;
    { bf16x8 qt[8];
#pragma unroll
      for (int d0 = 0; d0 < 8; ++d0) qt[d0] = *reinterpret_cast<const bf16x8*>(Qw + d0 * 16);
#pragma unroll
      for (int d0 = 0; d0 < 8; ++d0) *reinterpret_cast<LAS bf16x8*>(qr + d0 * 32) = qt[d0]; }
    const int sr = tid >> 4, sc = (tid & 15) * 8, vst0 = v_st(sr, sc), vst1 = v_st(32 + sr, sc);
    const unsigned goff0 = (unsigned)(sr * LDK + sc);
    const int vb0 = (int)(uintptr_t)V_lds + v_rd_base(lane);
    struct { bf16x8 vs0, vs1, ks0, ks1; } sr_[1];
#define TK0(j) (((j) < nvalid ? (j) : nvalid - 1) * KVBLK)
#define SLOAD(i, j) do { const bf16_t* vp_ = Vh + (size_t)TK0(j) * LDK; const bf16_t* kp_ = Kh + (size_t)TK0(j) * LDK; \
    sr_[i].vs0 = *reinterpret_cast<const bf16x8*>(vp_ + goff0); sr_[i].vs1 = *reinterpret_cast<const bf16x8*>(vp_ + goff0 + 32u * LDK); \
    sr_[i].ks0 = *reinterpret_cast<const bf16x8*>(kp_ + goff0); sr_[i].ks1 = *reinterpret_cast<const bf16x8*>(kp_ + goff0 + 32u * LDK); } while (0)
#define SWRITE(b, i) do { *(LAS bf16x8*)(V_lds + (b) * SHM_V + vst0) = sr_[i].vs0;          \
    *(LAS bf16x8*)(V_lds + (b) * SHM_V + vst1) = sr_[i].vs1; const int kc = sc * 2;               \
    *(LAS bf16x8*)(K_lds + (b) * SHM_K + KSWZ(sr, kc)) = sr_[i].ks0;                       \
    *(LAS bf16x8*)(K_lds + (b) * SHM_K + KSWZ(32 + sr, kc)) = sr_[i].ks1; } while (0)
#define SWAIT() asm volatile("s_waitcnt vmcnt(0)" ::: "memory")
#define RESC(a) do { if (__any((a) < 1.f)) { if (hi == 0) al_l[r32] = (a); asm volatile("s_waitcnt lgkmcnt(0)" ::: "memory"); \
    _Pragma("unroll") for (int d = 0; d < 4; ++d) _Pragma("unroll") for (int r = 0; r < 16; ++r) o[d][r] *= al_l[crow(r, hi)]; } } while (0)
#define MLOAD(j, lo_, hi_) do { if (MODE == 0) { unsigned long long w_ = ((j) < nvalid) ? mcol[(j) * 2048 + r32] : 0ull; lo_ = (unsigned)w_ >> (4 * hi); hi_ = (unsigned)(w_ >> 32) >> (4 * hi); } \
    else { lo_ = 0xFFFFFFFFu; hi_ = lo_; } } while (0)
#define BT(j) (btab + (bb0 + 64 * (j)))
    f32x16 pA0, pA1, pB0, pB1; float mnA, mnB, alA = 1.f, alB = 1.f; bf16x8 pa0, pa1, pa2, pa3;
    unsigned mAlo, mAhi, mBlo, mBhi;
#define LIVE(j) (MODE != 1 || ((j) >= jlo && (j) <= jhi))
#define QK_SM(P0_, P1_, KB_, MN_, AL_, j) do { if (LIVE(j)) { qkt(P0_, P1_, KB_, qr, r32, hi); partialSM<MODE>(P0_, P1_, m_reg, MN_, AL_, BT(j)); } else AL_ = 1.f; } while (0)
    constexpr int SE = 0, SO = 0;
    SLOAD(SE, 0); asm volatile("s_waitcnt vmcnt(0)" ::: "memory"); SWRITE(0, SE); __syncthreads();
    MLOAD(0, mAlo, mAhi);
    QK_SM(pA0, pA1, K_lds, mnA, alA, 0);
    SLOAD(SO, 1);
    SWAIT(); SWRITE(1, SO); __syncthreads();
    for (int j = 1; j + 1 < NT; j += 2) {
        MLOAD(j, mBlo, mBhi);
        SBAR(); if (LIVE(j)) qkt(pB0, pB1, K_lds + SHM_K, qr, r32, hi);
        if (LIVE(j - 1)) finishSM<MODE>(pA0, pA1, alA, l_reg, pa0, pa1, pa2, pa3, mAlo, mAhi); SBAR();
        SLOAD(SO, j + 1); SBAR();
        if (LIVE(j - 1)) pv_d0(o, vb0, pa0, pa1, pa2, pa3);
        if (LIVE(j)) partialSM<MODE>(pB0, pB1, m_reg, mnB, alB, BT(j)); else alB = 1.f;
        __syncthreads(); SWAIT(); SWRITE(0, SE);
        RESC(alB); __syncthreads();
        MLOAD(j + 1, mAlo, mAhi);
        SBAR(); if (LIVE(j + 1)) qkt(pA0, pA1, K_lds, qr, r32, hi);
        if (LIVE(j)) finishSM<MODE>(pB0, pB1, alB, l_reg, pa0, pa1, pa2, pa3, mBlo, mBhi); SBAR();
        SLOAD(SE, j + 2); SBAR();
        if (LIVE(j)) pv_d0(o, vb0 + SHM_V, pa0, pa1, pa2, pa3);
        if (LIVE(j + 1)) partialSM<MODE>(pA0, pA1, m_reg, mnA, alA, BT(j + 1)); else alA = 1.f;
        __syncthreads(); SWAIT(); SWRITE(1, SO);
        RESC(alA); __syncthreads();
    }
    MLOAD(NT - 1, mBlo, mBhi);
    SBAR(); if (LIVE(NT - 1)) qkt(pB0, pB1, K_lds + SHM_K, qr, r32, hi);
    if (LIVE(NT - 2)) finishSM<MODE>(pA0, pA1, alA, l_reg, pa0, pa1, pa2, pa3, mAlo, mAhi); SBAR();
    if (LIVE(NT - 2)) pv_d0(o, vb0, pa0, pa1, pa2, pa3);
    if (LIVE(NT - 1)) partialSM<MODE>(pB0, pB1, m_reg, mnB, alB, BT(NT - 1)); else alB = 1.f;
    __syncthreads(); RESC(alB);
    if (LIVE(NT - 1)) { finishSM<MODE>(pB0, pB1, alB, l_reg, pa0, pa1, pa2, pa3, mBlo, mBhi); SBAR();
        pv_d0(o, vb0 + SHM_V, pa0, pa1, pa2, pa3); }
#undef LIVE
#undef QK_SM
    asm volatile("s_waitcnt vmcnt(0)" ::: "memory");
    if (hi == 0) li_l[r32] = l_reg; asm volatile("s_waitcnt lgkmcnt(0)" ::: "memory");
    float rli[16];
#pragma unroll
    for (int r = 0; r < 16; ++r) rli[r] = __builtin_amdgcn_rcpf(li_l[crow(r, hi)]);
    int tz = tid; asm volatile("" : "+v"(tz)); const int r32z = tz & 31, hiz = (tz >> 5) & 1;
    if constexpr (OF8) {
        LAS unsigned char* st = (LAS unsigned char*)(lds + OFF_Q + wid * 8704);
#pragma unroll
        for (int r = 0; r < 16; ++r) { const int orow = crow(r, hiz); const float sc = rli[r] * 16.0f;
#pragma unroll
            for (int d0 = 0; d0 < 4; ++d0) st[orow * 144 + d0 * 32 + r32z] = (unsigned char)(__builtin_amdgcn_cvt_pk_fp8_f32(o[d0][r] * sc, 0.f, 0, false) & 0xffu); }
        asm volatile("s_waitcnt lgkmcnt(0)" ::: "memory");
        unsigned char* Ob = (unsigned char*)Ow; const int lz = tz & 63;
#pragma unroll
        for (int it = 0; it < 4; ++it) { const int ch = it * 64 + lz, row = ch >> 3, cc = ch & 7;
            const u32x4 w = *(const LAS u32x4*)(st + row * 144 + cc * 16); *(u32x4*)(Ob + (size_t)row * LDO + cc * 16) = w; }
    } else {
#pragma unroll
    for (int r = 0; r < 16; ++r) { const int orow = crow(r, hiz);
#pragma unroll
        for (int d0 = 0; d0 < 4; ++d0) Ow[orow * LDO + d0 * 32 + r32z] = (bf16_t)(cvtpk(o[d0][r] * rli[r], 0.f) & 0xffffu); }
    }
#undef TK0
#undef SLOAD
#undef SWRITE
#undef SWAIT
#undef RESC
#undef MLOAD
#undef BT
}
}

struct Args {
    const float* in[18]; float* out; unsigned char* ws;
};
struct Frame {
    LAS unsigned char* lds; int tid, lane, wave, G, bid;
    unsigned char* ws;
};

template <class RM>
__device__ __forceinline__ void cvt_tile(const float* __restrict__ W, int K, int N, bf16_t* __restrict__ WT, RM rm, LAS float* scr, int kb, int nb, int lane, const float* __restrict__ gk = nullptr) {
    const int k0 = 64 * kb, n0 = 64 * nb, n4 = (lane & 15) * 4;
    f32x4 v[16];
    const bool inb = (n0 + n4) < N;
#pragma unroll
    for (int i = 0; i < 16; ++i) { const int k = 4 * i + (lane >> 4); v[i] = inb ? *(const f32x4*)(W + (size_t)(k0 + k) * N + n0 + n4) : (f32x4){0.f, 0.f, 0.f, 0.f}; }
    if (gk) {
#pragma unroll
        for (int i = 0; i < 16; ++i) v[i] = v[i] * gk[k0 + 4 * i + (lane >> 4)]; }
#pragma unroll
    for (int i = 0; i < 16; ++i) { const int k = 4 * i + (lane >> 4); LAS float* s = scr + k * 65 + n4; s[0] = v[i][0]; s[1] = v[i][1]; s[2] = v[i][2]; s[3] = v[i][3]; }
    LDS_WAIT(); asm volatile("" ::: "memory");
    const int c = lane & 7;
#pragma unroll
    for (int j = 0; j < 8; ++j) { const int n = 8 * j + (lane >> 3); const LAS float* s = scr + (8 * c) * 65 + n;
        u32x4 o; o.x = cvt_pk_bf16(s[0 * 65], s[1 * 65]); o.y = cvt_pk_bf16(s[2 * 65], s[3 * 65]); o.z = cvt_pk_bf16(s[4 * 65], s[5 * 65]); o.w = cvt_pk_bf16(s[6 * 65], s[7 * 65]);
        if (n0 + n < N) *(u32x4*)(WT + (size_t)rm(n0 + n) * K + k0 + 8 * c) = o; }
    LDS_WAIT(); asm volatile("" ::: "memory");
}
struct RmId { int off; __device__ __forceinline__ int operator()(int n) const { return n + off; } };
struct RmInA {
    __device__ __forceinline__ int operator()(int n) const {
        const bool rope = (n < 5120) || (n >= 6144 && n < 10368);
        if (!rope) return n;
        const int d = n & 127, i = d & 63;
        return (n & ~127) + 8 * (i >> 2) + (i & 3) + 4 * (d >> 6);
    }
};
struct CvtDesc { const float* W; bf16_t* WT; const float* gk; int K, N, k0, n0, mode, off, f8, Kout, ko; float wsc; int* cs; };
__device__ __forceinline__ void cvt_load(const CvtDesc& d, f32x4 (&v)[16], int lane) {
    const int n4 = (lane & 15) * 4; const bool inb = (d.n0 + n4) < d.N;
    const float* p = d.W + (size_t)(d.k0 + (lane >> 4)) * d.N + d.n0 + n4;
#pragma unroll
    for (int i = 0; i < 16; ++i) v[i] = inb ? __builtin_nontemporal_load((const f32x4*)(p + (size_t)(4 * i) * d.N)) : (f32x4){0.f, 0.f, 0.f, 0.f};
}
__device__ __forceinline__ void cvt_store(const CvtDesc& d, const f32x4 (&v)[16], LAS float* scr, int lane) {
    const int n4 = (lane & 15) * 4;
#pragma unroll
    for (int i = 0; i < 16; ++i) { const int k = 4 * i + (lane >> 4); const float gg = d.gk ? d.gk[d.k0 + k] : 1.0f; LAS float* s = scr + k * 65 + n4; s[0] = v[i][0] * gg; s[1] = v[i][1] * gg; s[2] = v[i][2] * gg; s[3] = v[i][3] * gg; }
    LDS_WAIT(); asm volatile("" ::: "memory");
    const int c = lane & 7;
#pragma unroll
    for (int j = 0; j < 8; ++j) { const int n = d.n0 + 8 * j + (lane >> 3); const LAS float* s = scr + (8 * c) * 65 + 8 * j + (lane >> 3);
        u32x4 o; o.x = cvt_pk_bf16(s[0 * 65], s[1 * 65]); o.y = cvt_pk_bf16(s[2 * 65], s[3 * 65]); o.z = cvt_pk_bf16(s[4 * 65], s[5 * 65]); o.w = cvt_pk_bf16(s[6 * 65], s[7 * 65]);
        const int row = d.mode ? RmInA{}(n) : n + d.off;
        if (n < d.N) *(u32x4*)(d.WT + (size_t)row * d.K + d.k0 + 8 * c) = o; }
    LDS_WAIT(); asm volatile("" ::: "memory");
}
__device__ __forceinline__ void cvt_store_f8(const CvtDesc& d, const f32x4 (&v)[16], LAS float* scr, int lane) {
    const int n4 = (lane & 15) * 4;
#pragma unroll
    for (int i = 0; i < 16; ++i) { const int k = 4 * i + (lane >> 4); const float gg = (d.gk ? d.gk[d.k0 + k] : 1.0f) * d.wsc; LAS float* s = scr + k * 65 + n4; s[0] = v[i][0] * gg; s[1] = v[i][1] * gg; s[2] = v[i][2] * gg; s[3] = v[i][3] * gg; }
    LDS_WAIT(); asm volatile("" ::: "memory");
    const int c = lane & 3;
#pragma unroll
    for (int j = 0; j < 4; ++j) { const int nl = 16 * j + (lane >> 2), n = d.n0 + nl; const LAS float* s = scr + (16 * c) * 65 + nl;
        u32x4 o; o.x = cvt_pk_fp8(s[0 * 65], s[1 * 65], s[2 * 65], s[3 * 65]); o.y = cvt_pk_fp8(s[4 * 65], s[5 * 65], s[6 * 65], s[7 * 65]);
        o.z = cvt_pk_fp8(s[8 * 65], s[9 * 65], s[10 * 65], s[11 * 65]); o.w = cvt_pk_fp8(s[12 * 65], s[13 * 65], s[14 * 65], s[15 * 65]);
        const int row = d.mode ? RmInA{}(n) : n + d.off;
        if (n < d.N) *(u32x4*)((unsigned char*)d.WT + (size_t)row * d.Kout + d.ko + 16 * c) = o; }
    LDS_WAIT(); asm volatile("" ::: "memory");
}
__device__ __forceinline__ void cvt_store_i8(const CvtDesc& d, const f32x4 (&v)[16], LAS float* scr, int lane) {
    const int n4 = (lane & 15) * 4;
#pragma unroll
    for (int i = 0; i < 16; ++i) { const int k = 4 * i + (lane >> 4); const float gg = (d.gk ? d.gk[d.k0 + k] : 1.0f) * d.wsc; LAS float* s = scr + k * 65 + n4; s[0] = v[i][0] * gg; s[1] = v[i][1] * gg; s[2] = v[i][2] * gg; s[3] = v[i][3] * gg; }
    LDS_WAIT(); asm volatile("" ::: "memory");
    const int c = lane & 3;
#pragma unroll
    for (int j = 0; j < 4; ++j) { const int nl = 16 * j + (lane >> 2), n = d.n0 + nl; const LAS float* s = scr + (16 * c) * 65 + nl;
        unsigned wd[4]; int isum = 0;
#pragma unroll
        for (int w = 0; w < 4; ++w) { int q[4];
#pragma unroll
            for (int e = 0; e < 4; ++e) { q[e] = __float2int_rn(fminf(fmaxf(s[(4 * w + e) * 65], -127.f), 127.f)); isum += q[e]; }
            wd[w] = ((unsigned)q[0] & 255u) | (((unsigned)q[1] & 255u) << 8) | (((unsigned)q[2] & 255u) << 16) | ((unsigned)q[3] << 24); }
        const u32x4 o = {wd[0], wd[1], wd[2], wd[3]};
        const int row = d.mode ? RmInA{}(n) : n + d.off;
        if (n < d.N) *(u32x4*)((unsigned char*)d.WT + (size_t)row * d.Kout + d.ko + 16 * c) = o;
        if (d.cs) {
            isum += __builtin_amdgcn_update_dpp(0, isum, 0xB1, 0xF, 0xF, true); isum += __builtin_amdgcn_update_dpp(0, isum, 0x4E, 0xF, 0xF, true);
            if (c == 0 && n < d.N) atomicAdd(d.cs + row, isum); } }
    LDS_WAIT(); asm volatile("" ::: "memory");
}
__device__ __forceinline__ float est_sigma(const float* __restrict__ W, int N, const float* __restrict__ g, int lane) {
    float s = 0.f;
#pragma unroll
    for (int r = 0; r < 4; ++r) { const float gr = g ? g[r] : 1.0f;
#pragma unroll
        for (int j = 0; j < 4; ++j) { const f32x4 v = *(const f32x4*)(W + (size_t)r * N + 256 * j + 4 * lane) * gr; s += (v[0] * v[0] + v[1] * v[1]) + (v[2] * v[2] + v[3] * v[3]); } }
    return sqrtf(wave_sum(s) * (1.0f / 4096.0f));
}
template <bool OUTF>
__device__ __forceinline__ void rms_row(const float* xrow, const float* __restrict__ g, void* orow, int lane) {
    f32x4 v[16]; float s = 0.f;
#pragma unroll
    for (int j = 0; j < 16; ++j) { v[j] = ((const f32x4*)xrow)[64 * j + lane]; s += (v[j][0] * v[j][0] + v[j][1] * v[j][1]) + (v[j][2] * v[j][2] + v[j][3] * v[j][3]); }
    s = wave_sum(s);
    const float r = 1.0f / sqrtf(s * (1.0f / 4096.0f) + EPS);
#pragma unroll
    for (int j = 0; j < 16; ++j) { const f32x4 gg = ((const f32x4*)g)[64 * j + lane]; const f32x4 y = v[j] * r * gg;
        if (OUTF) ((f32x4*)orow)[64 * j + lane] = y;
        else { u32x2 w; w.x = cvt_pk_bf16(y[0], y[1]); w.y = cvt_pk_bf16(y[2], y[3]); ((u32x2*)orow)[64 * j + lane] = w; } }
}
__device__ __forceinline__ void cast_row(const float* xrow, bf16_t* orow, unsigned char* orow8, unsigned long long* ss, int lane) {
    f32x4 v[16]; float s = 0.f;
#pragma unroll
    for (int j = 0; j < 16; ++j) { v[j] = ((const f32x4*)xrow)[64 * j + lane]; s += (v[j][0] * v[j][0] + v[j][1] * v[j][1]) + (v[j][2] * v[j][2] + v[j][3] * v[j][3]);
        u32x2 w; w.x = cvt_pk_bf16(v[j][0], v[j][1]); w.y = cvt_pk_bf16(v[j][2], v[j][3]); ((u32x2*)orow)[64 * j + lane] = w; }
    s = wave_sum(s);
    const unsigned long long sf = ss_fix(s); const float qi = QINV * ss_rstd(sf);
#pragma unroll
    for (int j = 0; j < 16; ++j) ((unsigned*)orow8)[64 * j + lane] = pk_i8(v[j][0] * qi, v[j][1] * qi, v[j][2] * qi, v[j][3] * qi);
    if (lane == 0) *ss = sf;
}
__device__ __forceinline__ void final_row(const bf16_t* xrow, const float* __restrict__ g, unsigned long long ss, float* orow, int lane) {
    const float r = ss_rstd(ss);
#pragma unroll
    for (int j = 0; j < 8; ++j) { const u32x4 w = ((const u32x4*)xrow)[64 * j + lane]; const f32x4 g0 = ((const f32x4*)g)[128 * j + 2 * lane], g1 = ((const f32x4*)g)[128 * j + 2 * lane + 1];
        const f32x4 y0 = (f32x4){__uint_as_float(w.x << 16), __uint_as_float(w.x & 0xffff0000u), __uint_as_float(w.y << 16), __uint_as_float(w.y & 0xffff0000u)} * r * g0;
        const f32x4 y1 = (f32x4){__uint_as_float(w.z << 16), __uint_as_float(w.z & 0xffff0000u), __uint_as_float(w.w << 16), __uint_as_float(w.w & 0xffff0000u)} * r * g1;
        ((f32x4*)orow)[128 * j + 2 * lane] = y0; ((f32x4*)orow)[128 * j + 2 * lane + 1] = y1; }
}
__device__ __forceinline__ void rms_phase(const Frame& F, const float* x, const float* g, bf16_t* out, int rows) {
    const int gw = F.bid * 8 + F.wave, NGW = F.G * 8;
    for (int m = gw; m < rows; m += NGW) rms_row<false>(x + (size_t)m * DM, g, out + (size_t)m * DM, F.lane);
}

__device__ __forceinline__ void select_row(const float* __restrict__ SC, unsigned long long* __restrict__ MASKT, int b, int t, int lane) {
    const int chunk = t >> 6;
    const float* row = SC + (size_t)(b * SEQ + t) * SEQ;
    unsigned long long* mo = MASKT + (size_t)b * 32 * SEQ + t;
    if (chunk < 4) { if (lane < 32) mo[(size_t)lane * SEQ] = (lane <= chunk) ? ~0ull : 0ull; return; }
    unsigned key[32];
#pragma unroll
    for (int gI = 0; gI < 4; ++gI) {
        if (gI * 8 <= chunk) {
#pragma unroll
            for (int ii = 0; ii < 8; ++ii) { const int i = gI * 8 + ii; const unsigned u = __float_as_uint(row[64 * i + lane]);
                const unsigned k = (u & 0x80000000u) ? ~u : (u | 0x80000000u); key[i] = (i <= chunk) ? k : 0u; }
        } else {
#pragma unroll
            for (int ii = 0; ii < 8; ++ii) key[gI * 8 + ii] = 0u;
        }
    }
    unsigned T = 0u; bool exact = false;
    for (int bit = 31; bit >= 0; --bit) {
        const unsigned cand = T | (1u << bit);
        int cnt = 0;
#pragma unroll
        for (int gI = 0; gI < 4; ++gI) {
            if (gI * 8 <= chunk) {
#pragma unroll
                for (int ii = 0; ii < 8; ++ii) cnt += __popcll(__ballot(key[gI * 8 + ii] >= cand));
            }
        }
        if (cnt >= 256) T = cand;
        if (cnt == 256) { exact = true; break; }
    }
    if (exact) {
        unsigned long long myw = 0ull;
#pragma unroll
        for (int i = 0; i < 32; ++i) { const unsigned long long w = __ballot(key[i] >= T); myw = (lane == i) ? w : myw; }
        if (lane < 32) mo[(size_t)lane * SEQ] = myw;
        return; }
    int cgt = 0;
#pragma unroll
    for (int i = 0; i < 32; ++i) cgt += __popcll(__ballot(key[i] > T));
    const int need = 256 - cgt;
    int run = 0; unsigned long long myword = 0ull;
#pragma unroll
    for (int i = 0; i < 32; ++i) {
        const unsigned long long tie = __ballot(key[i] == T), gt = __ballot(key[i] > T);
        const int nt = __popcll(tie), take = need - run;
        unsigned long long sel = 0ull;
        if (take >= nt) sel = tie;
        else if (take > 0) { unsigned long long m = tie; for (int q = 0; q < take; ++q) { const unsigned long long lb = m & (0ull - m); sel |= lb; m ^= lb; } }
        run += nt;
        const unsigned long long w = gt | sel;
        myword = (lane == i) ? w : myword;
    }
    if (lane < 32) mo[(size_t)lane * SEQ] = myword;
}

__device__ __forceinline__ void select_rows2(const float* __restrict__ SC, unsigned long long* __restrict__ MASKT, int b, int tA, int tB, int lane) {
    const int chunk = tA >> 6;
    if (chunk < 4) { select_row(SC, MASKT, b, tA, lane); select_row(SC, MASKT, b, tB, lane); return; }
    const float* rowA = SC + (size_t)(b * SEQ + tA) * SEQ; const float* rowB = SC + (size_t)(b * SEQ + tB) * SEQ;
    unsigned kA[32], kB[32];
#pragma unroll
    for (int gI = 0; gI < 4; ++gI) {
        if (gI * 8 <= chunk) {
#pragma unroll
            for (int ii = 0; ii < 8; ++ii) { const int i = gI * 8 + ii; const unsigned ua = __float_as_uint(rowA[64 * i + lane]), ub = __float_as_uint(rowB[64 * i + lane]);
                const unsigned ka = (ua & 0x80000000u) ? ~ua : (ua | 0x80000000u), kb = (ub & 0x80000000u) ? ~ub : (ub | 0x80000000u);
                kA[i] = (i <= chunk) ? ka : 0u; kB[i] = (i <= chunk) ? kb : 0u; }
        } else {
#pragma unroll
            for (int ii = 0; ii < 8; ++ii) { kA[gI * 8 + ii] = 0u; kB[gI * 8 + ii] = 0u; }
        }
    }
    unsigned TA = 0u, TB = 0u; bool exA = false, exB = false;
    for (int bit = 31; bit >= 0; --bit) {
        const unsigned candA = exA ? TA : (TA | (1u << bit)), candB = exB ? TB : (TB | (1u << bit));
        int cntA = 0, cntB = 0;
#pragma unroll
        for (int gI = 0; gI < 4; ++gI) {
            if (gI * 8 <= chunk) {
#pragma unroll
                for (int ii = 0; ii < 8; ++ii) { cntA += __popcll(__ballot(kA[gI * 8 + ii] >= candA)); cntB += __popcll(__ballot(kB[gI * 8 + ii] >= candB)); }
            }
        }
        if (cntA >= 256) TA = candA;
        if (cntB >= 256) TB = candB;
        exA = exA || (cntA == 256); exB = exB || (cntB == 256);
        if (exA && exB) break;
    }
#pragma unroll
    for (int h = 0; h < 2; ++h) {
        const unsigned T = h ? TB : TA; const bool exact = h ? exB : exA;
        unsigned long long* mo = MASKT + (size_t)b * 32 * SEQ + (h ? tB : tA);
        unsigned long long myword = 0ull;
        if (exact) {
#pragma unroll
            for (int i = 0; i < 32; ++i) { const unsigned long long w = __ballot((h ? kB[i] : kA[i]) >= T); myword = (lane == i) ? w : myword; }
        } else {
            int cgt = 0;
#pragma unroll
            for (int i = 0; i < 32; ++i) cgt += __popcll(__ballot((h ? kB[i] : kA[i]) > T));
            const int need = 256 - cgt; int run = 0;
#pragma unroll
            for (int i = 0; i < 32; ++i) { const unsigned kk = h ? kB[i] : kA[i];
                const unsigned long long tie = __ballot(kk == T), gt = __ballot(kk > T);
                const int nt = __popcll(tie), take = need - run;
                unsigned long long sel = 0ull;
                if (take >= nt) sel = tie;
                else if (take > 0) { unsigned long long m = tie; for (int q = 0; q < take; ++q) { const unsigned long long lb = m & (0ull - m); sel |= lb; m ^= lb; } }
                run += nt;
                const unsigned long long w = gt | sel;
                myword = (lane == i) ? w : myword; }
        }
        if (lane < 32) mo[(size_t)lane * SEQ] = myword;
    }
}

__device__ __forceinline__ void indexer_unit(LAS unsigned char* lds, const bf16_t* __restrict__ QI, const bf16_t* __restrict__ KI, const float* __restrict__ WI, float* SC, unsigned long long* __restrict__ MASKT, int b, int qb, int tid_in) {
    int tid_ = tid_in; asm volatile("" : "+v"(tid_)); const int tid = tid_;
    const int wid = tid >> 6, lane = tid & 63, r32 = lane & 31, hf = lane >> 5;
    const int t0 = qb * 16, NP = (qb >> 2) + 1;
    LAS unsigned char* kbuf = lds;
    LAS float* wiT = (LAS float*)(lds + 32768);
    __syncthreads();
    for (int e = tid; e < 512; e += 512) { const int tl = e >> 5, h2 = (e >> 4) & 1, r = e & 15, head = (r & 3) + 8 * (r >> 2) + 4 * h2;
        wiT[e] = WI[(size_t)(b * SEQ + t0 + tl) * 32 + head]; }
    bf16x8 qa[2][8];
#pragma unroll
    for (int i = 0; i < 2; ++i) { const bf16_t* qp = QI + (size_t)(b * SEQ + t0 + wid + 8 * i) * 4096 + r32 * 128 + hf * 8;
#pragma unroll
        for (int s = 0; s < 8; ++s) qa[i][s] = *(const bf16x8*)(qp + 16 * s); }
    const int sr = tid >> 4, scb = (tid & 15) * 16;
    const bf16_t* kg = KI + (size_t)(b * SEQ) * 128 + (tid & 15) * 8;
    bf16x8 st0, st1;
#define ILOAD(k0) do { st0 = *(const bf16x8*)(kg + (size_t)((k0) + sr) * 128); st1 = *(const bf16x8*)(kg + (size_t)((k0) + 32 + sr) * 128); } while (0)
#define IWRITE(buf) do { *(LAS bf16x8*)(kbuf + (buf) * 16384 + KSWZ(sr, scb)) = st0; *(LAS bf16x8*)(kbuf + (buf) * 16384 + KSWZ(32 + sr, scb)) = st1; } while (0)
    ILOAD(0); IWRITE(0); __syncthreads();
    for (int jp = 0; jp < NP; ++jp) {
        if (jp + 1 < NP) ILOAD((jp + 1) * 64);
        const LAS unsigned char* kb_ = kbuf + (jp & 1) * 16384;
        float pa[2], pb[2];
#pragma unroll
        for (int a = 0; a < 2; ++a) {
            bf16x8 kf[8];
#pragma unroll
            for (int s = 0; s < 8; ++s) kf[s] = *(const LAS bf16x8*)(kb_ + KSWZ(32 * a + r32, (16 * s + 8 * hf) * 2));
#pragma unroll
            for (int i = 0; i < 2; ++i) {
                f32x16 d = {};
#pragma unroll
                for (int s = 0; s < 8; ++s) d = __builtin_amdgcn_mfma_f32_32x32x16_bf16(qa[i][s], kf[s], d, 0, 0, 0);
                const LAS f32x4* wp = (const LAS f32x4*)(wiT + ((wid + 8 * i) * 2 + hf) * 16);
                const f32x4 w0 = wp[0], w1 = wp[1], w2 = wp[2], w3 = wp[3];
                float p = 0.f;
#pragma unroll
                for (int r = 0; r < 4; ++r) { p = fmaf(w0[r], fmaxf(d[r], 0.f), p); p = fmaf(w1[r], fmaxf(d[4 + r], 0.f), p); p = fmaf(w2[r], fmaxf(d[8 + r], 0.f), p); p = fmaf(w3[r], fmaxf(d[12 + r], 0.f), p); }
                if (a == 0) pa[i] = p; else pb[i] = p;
            }
        }
#pragma unroll
        for (int i = 0; i < 2; ++i) { auto rr = __builtin_amdgcn_permlane32_swap(__float_as_uint(pa[i]), __float_as_uint(pb[i]), false, false);
            SC[(size_t)(b * SEQ + t0 + wid + 8 * i) * SEQ + 64 * jp + lane] = __uint_as_float(rr[0]) + __uint_as_float(rr[1]); }
        if (jp + 1 < NP) IWRITE((jp + 1) & 1);
        __syncthreads();
    }
#undef ILOAD
#undef IWRITE
    asm volatile("s_waitcnt vmcnt(0)" ::: "memory");
    select_rows2(SC, MASKT, b, t0 + wid, t0 + wid + 8, lane);
}

__device__ __forceinline__ unsigned char* launder(unsigned char* p) { size_t z = 0; asm volatile("" : "+s"(z)); return p + z; }
#define WSP(T, off) ((T*)(ws + (off)))
#define PHASE_BEGIN() unsigned char* ws = launder(args.ws); Frame F; F.lds = (LAS unsigned char*)lds_raw; { int t_ = (wv0 << 6) | hw_lane(); asm volatile("" : "+v"(t_)); F.tid = t_; int b_ = blockIdx.x; asm volatile("" : "+s"(b_)); F.bid = b_; } F.lane = F.tid & 63; F.wave = __builtin_amdgcn_readfirstlane(F.tid >> 6); F.G = gridDim.x; F.ws = ws
#define GRID_BAR() do { unsigned char* wsb = launder(args.ws); XcdBarrier bar_; bar_.bar = (unsigned*)(wsb + WS_CTL) + CW_BAR; bar_.x = xb_xcc_id(); bar_.st = (volatile LAS unsigned*)((LAS unsigned char*)lds_raw + MISC_OFF); bar_.lead = (wv0 == 0) && (hw_lane() == 0); xcd_barrier(bar_); } while (0)

template <int L> __device__ __forceinline__ void layer_fwd(const Args& args, unsigned char* lds_raw, const int wv0) {
        if constexpr (L == 0) {
DUP(9,
            { PHASE_BEGIN();
              { pg8::Gemm g{WSP(bf16_t, WS_X8), WSP(bf16_t, WS_WA_IN8), MTOK, 6144, DM, 0}; pg8::StaticOrder S; S.init(MTOK, 6144, F.G, F.bid);
                pg8::EpiInA E{WSP(bf16_t, WS_Q), WSP(bf16_t, WS_K0), WSP(bf16_t, WS_V0), WSP(bf16_t, WS_QI), WSP(bf16_t, WS_KI), WSP(float, WS_WI), WSP(float, WS_COS), WSP(float, WS_SIN), nullptr, 0, QMUL * ((const float*)(ws + WS_QS))[4]};
                pg8::gemm_phase<pg8::EpiInA, pg8::StaticOrder, true, true, 2>(F.lds, g, S, E, F.tid); }
              { pg8::Gemm g{WSP(bf16_t, WS_HN), WSP(bf16_t, WS_WA_IN) + (size_t)6144 * DM, MTOK, A_IN_PAD - 6144, DM, 0}; pg8::StaticOrder S; S.init(MTOK, A_IN_PAD - 6144, F.G, F.bid);
                pg8::EpiInA E{WSP(bf16_t, WS_Q), WSP(bf16_t, WS_K0), WSP(bf16_t, WS_V0), WSP(bf16_t, WS_QI), WSP(bf16_t, WS_KI), WSP(float, WS_WI), WSP(float, WS_COS), WSP(float, WS_SIN), SSP(0), 48, 1.0f};
                pg8::gemm_phase<pg8::EpiInA, pg8::StaticOrder, true, true>(F.lds, g, S, E, F.tid); }
              for (int l2 = 0; l2 < 2; ++l2) {
                pg8::Gemm g{WSP(bf16_t, WS_MEMN), WSP(bf16_t, WS_WMKV) + (size_t)l2 * 1024 * DM, BATCH * MEMT, 1024, DM, 0}; pg8::StaticOrder S; S.init(BATCH * MEMT, 1024, F.G, (F.bid + F.G - 64 - 32 * l2) % F.G);
                pg8::EpiBf16<0> E{WSP(bf16_t, WS_MKV) + (size_t)l2 * BATCH * MEMT * 1024, 1024, 0, 0, nullptr, 1.0f, nullptr, nullptr};
                pg8::gemm_phase<pg8::EpiBf16<0>, pg8::StaticOrder, true, true>(F.lds, g, S, E, F.tid); } }
            GRID_BAR();
)
DUP(2,
            { PHASE_BEGIN();
              for (int u = F.bid; u < 512; u += F.G) { const int b = u & 7, j = u >> 3;
                for (int k2 = 0; k2 < 2; ++k2) indexer_unit(F.lds, WSP(bf16_t, WS_QI), WSP(bf16_t, WS_KI), WSP(float, WS_WI), WSP(float, WS_SC), WSP(unsigned long long, WS_MASK), b, k2 ? 127 - j : j, F.tid); } }
            GRID_BAR();
)
DUP(4,
            { PHASE_BEGIN();
              bf16_t* Qb = WSP(bf16_t, WS_Q); const bf16_t* K0 = WSP(bf16_t, WS_K0); const bf16_t* V0 = WSP(bf16_t, WS_V0); const unsigned long long* MASKT = WSP(unsigned long long, WS_MASK);
              for (int pu = F.bid; pu < 1024; pu += F.G) {
                const int xcd = pu & 7, slot = (pu >> 3) & 31, rnd = pu >> 8;
                const int combo = xcd * 8 + 2 * rnd + (slot >> 4), pair = slot & 15, b = combo >> 3, kvh = combo & 7;
                for (int hh = 0; hh < 2; ++hh) { const int c = hh ? 31 - pair : pair;
                    const int nvalid = c + 1, NT = (nvalid + 1) & ~1;
                    const int hq = kvh * 4 + (F.wave >> 1), tok0 = 64 * c + 32 * (F.wave & 1), r32 = F.lane & 31, hi = F.lane >> 5;
                    const bf16_t* Qw = Qb + (size_t)(b * SEQ + tok0 + r32) * 4096 + hq * 128 + hi * 8;
                    const bf16_t* Kh = K0 + (size_t)(b * SEQ) * 1024 + kvh * 128; const bf16_t* Vh = V0 + (size_t)(b * SEQ) * 1024 + kvh * 128;
                    bf16_t* Ow = (bf16_t*)(WSP(unsigned char, WS_O) + (size_t)(b * SEQ + tok0) * 4096 + hq * 128);
                    const unsigned long long* mcol = MASKT + (size_t)b * 32 * SEQ + tok0;
                    __syncthreads();
                    att::attn_body<0, 4096, 1024, 4096, true>(Qw, Kh, Vh, Ow, NT, nvalid, mcol, 0, 0, 0, (LAS char*)F.lds, F.tid); }
              } }
            GRID_BAR();
)
        } else {
DUP(10,
            { PHASE_BEGIN();
              pg8::Gemm g{WSP(bf16_t, WS_X8), WSP(bf16_t, WS_WB_IN), MTOK, B_IN, DM, 0}; pg8::StaticOrder S; S.init(MTOK, B_IN, F.G, F.bid);
              pg8::EpiBf16<0> E{WSP(bf16_t, WS_Q), 4096, 4096, (size_t)(WS_K1 - WS_Q) / 2, SSP(3), QMUL * ((const float*)(ws + WS_QS))[5], nullptr, SSP(2)};
              pg8::gemm_phase<pg8::EpiBf16<0>, pg8::StaticOrder, true, true, 2>(F.lds, g, S, E, F.tid); }
            GRID_BAR();
)
DUP(5,
            { PHASE_BEGIN();
              bf16_t* Qb = WSP(bf16_t, WS_Q); const bf16_t* K1 = WSP(bf16_t, WS_K1); const bf16_t* V1 = WSP(bf16_t, WS_V1);
              for (int bh = F.bid; bh < 256; bh += F.G) { const int b = bh >> 5, h = bh & 31;
                __syncthreads();
                { LAS float* bt = (LAS float*)(F.lds + att::OFF_BT); const float* rb = args.in[10] + (size_t)h * 513;
                  for (int uI = F.tid; uI < 1024; uI += 512) { int rel = 767 - uI; rel = rel < -256 ? -256 : (rel > 256 ? 256 : rel); bt[uI] = rb[rel + 256] * 1.4426950408889634f; } }
                for (int cg = 0; cg < 8; ++cg) {
                    const int tlo = (4 * cg - 8) > 0 ? (4 * cg - 8) : 0, NT = 4 * cg + 4 - tlo;
                    const int cw = 4 * cg + (F.wave >> 1), r32 = F.lane & 31, hi = F.lane >> 5;
                    const int qpos = 64 * cw + 32 * (F.wave & 1) + r32;
                    const int jlo = ((cw - 8) > 0 ? (cw - 8) : 0) - tlo, jhi = cw - tlo;
                    const bf16_t* Qw = Qb + (size_t)(b * SEQ + qpos) * 4096 + h * 128 + hi * 8;
                    const bf16_t* Kh = K1 + (size_t)(b * SEQ + 64 * tlo) * 4096 + h * 128; const bf16_t* Vh = V1 + (size_t)(b * SEQ + 64 * tlo) * 4096 + h * 128;
                    bf16_t* Ow = (bf16_t*)(WSP(unsigned char, WS_O) + (size_t)(b * SEQ + 64 * cw + 32 * (F.wave & 1)) * 4096 + h * 128);
                    const int bb0 = 767 - qpos + 64 * tlo + 4 * hi;
                    __syncthreads();
                    att::attn_body<1, 4096, 4096, 4096, true>(Qw, Kh, Vh, Ow, NT, NT, nullptr, jlo, jhi, bb0, (LAS char*)F.lds, F.tid); }
              } }
            GRID_BAR();
)
        }
DUP(13,
        { PHASE_BEGIN();
          pg8::Gemm g{WSP(bf16_t, WS_O), L ? WSP(bf16_t, WS_WB_OUT) : WSP(bf16_t, WS_WA_OUT), MTOK, DM, DM, 0}; pg8::StaticOrder S; S.init(MTOK, DM, F.G, F.bid);
          pg8::EpiResB<false> E{nullptr, WSP(bf16_t, WS_HN), dup_ ? SSD : SSP(1 + 3 * L), dup_ ? 0.0f : 1.0f / 1024.0f, nullptr, nullptr, (LAS float*)(F.lds + 131072)};
          pg8::gemm_phase<pg8::EpiResB<false>, pg8::StaticOrder, true, true, true>(F.lds, g, S, E, F.tid); }
        GRID_BAR();
)
DUP(12,
        { PHASE_BEGIN();
          pg8::Gemm g{WSP(bf16_t, WS_HN), WSP(bf16_t, WS_WMQ) + (size_t)L * MEMD * DM, MTOK, MEMD, DM, 0}; pg8::StaticOrder S; S.init(MTOK, MEMD, F.G, F.bid);
          pg8::EpiBf16<0> E{WSP(bf16_t, WS_MQ), MEMD, 0, 0, SSP(1 + 3 * L), 1.0f, nullptr, nullptr};
          pg8::gemm_phase<pg8::EpiBf16<0>, pg8::StaticOrder, true, true>(F.lds, g, S, E, F.tid); }
        GRID_BAR();
)
DUP(6,
        { PHASE_BEGIN();
          bf16_t* MQ = WSP(bf16_t, WS_MQ); const bf16_t* MKV = WSP(bf16_t, WS_MKV) + (size_t)L * BATCH * MEMT * 1024;
          for (int u = F.bid; u < 256; u += F.G) { const int b = u >> 5, mh = (u >> 3) & 3, tb = u & 7;
            const int r32 = F.lane & 31, hi = F.lane >> 5;
            const bf16_t* Qw = MQ + (size_t)(b * SEQ + 256 * tb + 32 * F.wave + r32) * MEMD + mh * 128 + hi * 8;
            const bf16_t* Kh = MKV + (size_t)(b * MEMT) * 1024 + mh * 128; const bf16_t* Vh = Kh + 512;
            bf16_t* Ow = WSP(bf16_t, WS_MO) + (size_t)(b * SEQ + 256 * tb + 32 * F.wave) * MEMD + mh * 128;
            __syncthreads();
            att::attn_body<2, MEMD, 1024, MEMD>(Qw, Kh, Vh, Ow, 4, 4, nullptr, 0, 0, 0, (LAS char*)F.lds, F.tid); } }
        GRID_BAR();
)
DUP(14,
        { PHASE_BEGIN();
          pg8::Gemm g{WSP(bf16_t, WS_MO), WSP(bf16_t, WS_WMO) + (size_t)L * DM * MEMD, MTOK, DM, MEMD, 0}; pg8::StaticOrder S; S.init(MTOK, DM, F.G, F.bid);
          pg8::EpiResB<false, 2> E{nullptr, WSP(bf16_t, WS_HN), dup_ ? SSD : SSP(2 + 3 * L), dup_ ? 0.0f : 1.0f, SSP(1 + 3 * L), nullptr, (LAS float*)(F.lds + 131072)};
          pg8::gemm_phase<pg8::EpiResB<false, 2>, pg8::StaticOrder, true, true>(F.lds, g, S, E, F.tid); }
        GRID_BAR();
)
DUP(7,
        { PHASE_BEGIN();
          pg8::Gemm g{WSP(bf16_t, WS_X8), WSP(bf16_t, WS_WUP) + (size_t)L * DFF * DM, MTOK, DFF, DM, 0}; pg8::StaticOrder S; S.init(MTOK, DFF, F.G, F.bid, pg8::WGM_UP);
          const float qs_up = ((const float*)(ws + WS_QS))[L], sig_z = 64.0f * qs_up * (1.0f / QMUL), a_clip = (C_A * sig_z) * (C_A * sig_z);
          pg8::EpiHidI8 E{WSP(unsigned char, WS_A1), DFF, SSP(2 + 3 * L), QMUL * qs_up * (15.968719422671311f / (C_A * sig_z)), SSP(1 + 3 * L), 255.0f / a_clip};
          pg8::gemm_phase<pg8::EpiHidI8, pg8::StaticOrder, true, true, 2>(F.lds, g, S, E, F.tid); }
        GRID_BAR();
)
DUP(15,
        { PHASE_BEGIN();
          const float* qs = (const float*)(ws + WS_QS); const float sig_z = 64.0f * qs[L] * (1.0f / QMUL), a_clip = (C_A * sig_z) * (C_A * sig_z);
          pg8::Gemm g{WSP(bf16_t, WS_A1), WSP(bf16_t, WS_WDN) + (size_t)L * DM * DFF, MTOK, DM, DFF, 0}; pg8::StaticOrder S; S.init(MTOK, DM, F.G, F.bid, pg8::WGM_DN);
          pg8::EpiResB<false, L == 0 ? 2 : 0, false, true> E{nullptr, WSP(bf16_t, WS_HN), dup_ ? SSD : SSP(3 + 3 * L), dup_ ? 0.0f : a_clip * (1.0f / 255.0f) * qs[2 + L], SSP(2 + 3 * L), (const int*)(ws + WS_CS) + L * DM, (LAS float*)(F.lds + 131072)};
          pg8::gemm_phase<pg8::EpiResB<false, L == 0 ? 2 : 0, false, true>, pg8::StaticOrder, true, true, 2>(F.lds, g, S, E, F.tid); }
        GRID_BAR();
)
}

__global__ void __launch_bounds__(512, 2) trunk_fwd(Args args) {
    extern __shared__ __attribute__((aligned(16))) unsigned char lds_raw[];
    const int wv0 = __builtin_amdgcn_readfirstlane((int)(threadIdx.x >> 6));
    {
        volatile LAS unsigned* MISC = (volatile LAS unsigned*)((LAS unsigned char*)lds_raw + MISC_OFF);
        if (threadIdx.x < 16) MISC[threadIdx.x] = 0u;
        __syncthreads();
        (void)xcd_barrier_post((unsigned*)(args.ws + WS_CTL) + CW_BAR, MISC);
    }

DUP(0,
    {
        PHASE_BEGIN();
        LAS float* scr = (LAS float*)(F.lds + F.wave * 16640);
        const int gw = F.bid * 8 + F.wave, NGW = F.G * 8;
        constexpr int T_INA = 64 * 163, T_OUT = 64 * 64, T_INB = 64 * 192, T_M = 2 * 64 * 8, T_MO = 2 * 8 * 64, T_UP = 2 * 64 * 256, T_DN = 2 * 256 * 64;
        constexpr int NITEMS = T_INA + T_OUT + T_INB + T_OUT + 3 * T_M + T_MO + T_UP + T_DN;
        const float sig_up0 = est_sigma(args.in[16], DFF, args.in[4], F.lane), sig_up1 = est_sigma(args.in[16] + (size_t)DM * DFF, DFF, args.in[4] + DM, F.lane);
        const float sig_dn0 = est_sigma(args.in[17], DM, nullptr, F.lane), sig_dn1 = est_sigma(args.in[17] + (size_t)DFF * DM, DM, nullptr, F.lane);
        const float sig_ina = est_sigma(args.in[7], A_IN, args.in[2], F.lane), sig_inb = est_sigma(args.in[9], B_IN, args.in[2] + DM, F.lane);
        if (gw == 0 && F.lane == 0) { float* qs = (float*)(ws + WS_QS); qs[0] = sig_up0 * QMUL; qs[1] = sig_up1 * QMUL; qs[2] = sig_dn0 * QMUL; qs[3] = sig_dn1 * QMUL; qs[4] = sig_ina * QMUL; qs[5] = sig_inb * QMUL; }
        auto decode = [&](int it) -> CvtDesc {
            CvtDesc d; int r = it; d.mode = 0; d.off = 0; d.gk = nullptr; d.f8 = 0; d.wsc = 64.0f; d.Kout = -1; d.ko = 0; d.cs = nullptr;
            if (r < T_INA) { d.W = args.in[7]; d.K = DM; d.N = A_IN; d.WT = WSP(bf16_t, WS_WA_IN); d.mode = 1; d.gk = args.in[2]; d.k0 = 64 * (2 * (r / 326) + (r & 1)); d.n0 = 64 * ((r % 326) >> 1);
                if (d.n0 < 6144) { d.f8 = 2; d.wsc = QINV / sig_ina; d.WT = WSP(bf16_t, WS_WA_IN8); }
                return d; } r -= T_INA;
            if (r < T_OUT) { d.W = args.in[8]; d.K = DM; d.N = DM; d.WT = WSP(bf16_t, WS_WA_OUT); d.f8 = 1; d.k0 = 64 * (2 * (r / 128) + (r & 1)); d.n0 = 64 * ((r % 128) >> 1); return d; } r -= T_OUT;
            if (r < T_INB) { d.W = args.in[9]; d.K = DM; d.N = B_IN; d.WT = WSP(bf16_t, WS_WB_IN); d.f8 = 2; d.wsc = QINV / sig_inb; d.gk = args.in[2] + DM; d.k0 = 64 * (2 * (r / 384) + (r & 1)); d.n0 = 64 * ((r % 384) >> 1); return d; } r -= T_INB;
            if (r < T_OUT) { d.W = args.in[11]; d.K = DM; d.N = DM; d.WT = WSP(bf16_t, WS_WB_OUT); d.f8 = 1; d.k0 = 64 * (2 * (r / 128) + (r & 1)); d.n0 = 64 * ((r % 128) >> 1); return d; } r -= T_OUT;
            if (r < T_M) { const int L = r / 512, q = r % 512; d.W = args.in[12] + (size_t)L * DM * MEMD; d.K = DM; d.N = MEMD; d.WT = WSP(bf16_t, WS_WMQ) + (size_t)L * MEMD * DM; d.gk = args.in[3] + (size_t)L * DM; d.k0 = 64 * (q / 8); d.n0 = 64 * (q % 8); return d; } r -= T_M;
            if (r < T_M) { const int L = r / 512, q = r % 512; d.W = args.in[13] + (size_t)L * DM * MEMD; d.K = DM; d.N = MEMD; d.WT = WSP(bf16_t, WS_WMKV) + (size_t)L * 1024 * DM; d.k0 = 64 * (q / 8); d.n0 = 64 * (q % 8); return d; } r -= T_M;
            if (r < T_M) { const int L = r / 512, q = r % 512; d.W = args.in[14] + (size_t)L * DM * MEMD; d.K = DM; d.N = MEMD; d.WT = WSP(bf16_t, WS_WMKV) + (size_t)L * 1024 * DM; d.off = 512; d.k0 = 64 * (q / 8); d.n0 = 64 * (q % 8); return d; } r -= T_M;
            if (r < T_MO) { const int L = r / 512, q = r % 512; d.W = args.in[15] + (size_t)L * MEMD * DM; d.K = MEMD; d.N = DM; d.WT = WSP(bf16_t, WS_WMO) + (size_t)L * DM * MEMD; d.k0 = 64 * (q / 64); d.n0 = 64 * (q % 64); return d; } r -= T_MO;
            if (r < T_UP) { const int L = r / 16384, q = r % 16384; d.W = args.in[16] + (size_t)L * DM * DFF; d.K = DM; d.N = DFF; d.WT = WSP(bf16_t, WS_WUP) + (size_t)L * DFF * DM; d.gk = args.in[4] + (size_t)L * DM; d.k0 = 64 * (2 * (q / 512) + (q & 1)); d.n0 = 64 * ((q % 512) >> 1);
              d.f8 = 2; d.wsc = QINV / (L ? sig_up1 : sig_up0);
              return d; } r -= T_UP;
            { const int L = r / 16384, q = r % 16384; d.W = args.in[17] + (size_t)L * DFF * DM; d.K = DFF; d.N = DM; d.WT = WSP(bf16_t, WS_WDN) + (size_t)L * DM * DFF; d.k0 = 64 * (2 * (q / 128) + (q & 1)); d.n0 = 64 * ((q % 128) >> 1);
              d.f8 = 2; d.wsc = QINV / (L ? sig_dn1 : sig_dn0); d.cs = dup_ ? nullptr : (int*)(ws + WS_CS) + L * DM;
              return d; }
        };
        { f32x4 va[16], vb[16]; CvtDesc da, db; int it = gw;
          auto dec2 = [&](int t) -> CvtDesc { CvtDesc d = decode(t); if (d.Kout < 0) { d.Kout = d.K; d.ko = d.k0; } return d; };
          if (it < NITEMS) { da = dec2(it); cvt_load(da, va, F.lane); }
          while (it < NITEMS) {
              const int it2 = it + NGW; const bool h2 = it2 < NITEMS;
              if (h2) { db = dec2(it2); cvt_load(db, vb, F.lane); }
              if (da.f8 == 2) cvt_store_i8(da, va, scr, F.lane); else if (da.f8) cvt_store_f8(da, va, scr, F.lane); else cvt_store(da, va, scr, F.lane);
              if (!h2) break;
              const int it3 = it2 + NGW; const bool h3 = it3 < NITEMS;
              if (h3) { da = dec2(it3); cvt_load(da, va, F.lane); }
              if (db.f8 == 2) cvt_store_i8(db, vb, scr, F.lane); else if (db.f8) cvt_store_f8(db, vb, scr, F.lane); else cvt_store(db, vb, scr, F.lane);
              it = it3; } }
        { u32x4* p = (u32x4*)(WSP(bf16_t, WS_WA_IN) + (size_t)A_IN * DM); const int n16 = (A_IN_PAD - A_IN) * DM * 2 / 16;
          for (int i = F.bid * 512 + F.tid; i < n16; i += F.G * 512) p[i] = (u32x4){0u, 0u, 0u, 0u}; }
        { float* COS = WSP(float, WS_COS); float* SIN = WSP(float, WS_SIN);
          for (int i = F.bid * 512 + F.tid; i < SEQ * 64; i += F.G * 512) { const int pos = i >> 6, fi = i & 63;
            const float inv = __builtin_amdgcn_exp2f(-(float)fi * (13.287712379549449f / 64.0f));
            double rev = (double)pos * (double)inv * 0.15915494309189535; rev -= __builtin_rint(rev);
            const float fr = (float)rev; COS[i] = __builtin_amdgcn_cosf(fr); SIN[i] = __builtin_amdgcn_sinf(fr); } }
        for (int m = gw; m < BATCH * MEMT; m += NGW) rms_row<false>(args.in[1] + (size_t)m * DM, args.in[5], WSP(bf16_t, WS_MEMN) + (size_t)m * DM, F.lane);
        for (int m = gw; m < MTOK; m += NGW) cast_row(args.in[0] + (size_t)m * DM, WSP(bf16_t, WS_HN) + (size_t)m * DM, WSP(unsigned char, WS_X8) + (size_t)m * DM, SSP(0) + m, F.lane);
    }
    GRID_BAR();
)

    layer_fwd<0>(args, lds_raw, wv0);
    layer_fwd<1>(args, lds_raw, wv0);
    { PHASE_BEGIN();
      for (int m = F.bid * 8 + F.wave; m < MTOK; m += F.G * 8) final_row(WSP(bf16_t, WS_HN) + (size_t)m * DM, args.in[6], SSP(6)[m], args.out + (size_t)m * DM, F.lane); }
}

extern "C" void kernel_launch(void* const* d_in, const int* in_sizes, int n_in, void* d_out, int out_size, void* d_ws, size_t ws_size, hipStream_t stream) {
    static int grid = 0;
    if (grid == 0) {
        if (n_in != 18 || in_sizes[0] != MTOK * DM || out_size != MTOK * DM || ws_size < WS_END) {
            fprintf(stderr, "kernel_launch: unexpected shapes: n_in %d in0 %d out %d ws %zu (need %zu)\n", n_in, n_in > 0 ? in_sizes[0] : -1, out_size, ws_size, (size_t)WS_END); grid = -1; return; }
        int dev = 0, cus = 0, per_cu = 0;
        if (hipGetDevice(&dev) != hipSuccess || hipDeviceGetAttribute(&cus, hipDeviceAttributeMultiprocessorCount, dev) != hipSuccess) { grid = -1; return; }
        if (hipFuncSetAttribute((const void*)trunk_fwd, hipFuncAttributeMaxDynamicSharedMemorySize, LDS_BYTES) != hipSuccess) { fprintf(stderr, "kernel_launch: hipFuncSetAttribute failed\n"); grid = -1; return; }
        if (hipOccupancyMaxActiveBlocksPerMultiprocessor(&per_cu, (const void*)trunk_fwd, 512, LDS_BYTES) != hipSuccess || per_cu < 1) { fprintf(stderr, "kernel_launch: occupancy query says %d\n", per_cu); }
        (void)hipGetLastError();
        grid = cus;
    }
    if (grid < 0) return;
    (void)hipMemsetAsync((char*)d_ws + WS_CTL, 0, CTL_ZERO_BYTES, stream);
    Args a{};
    for (int i = 0; i < 18; ++i) a.in[i] = (const float*)d_in[i];
    a.out = (float*)d_out; a.ws = (unsigned char*)d_ws;
    hipLaunchKernelGGL(trunk_fwd, dim3(grid), dim3(512), LDS_BYTES, stream, a);
    const hipError_t le = hipPeekAtLastError();
    if (le != hipSuccess) fprintf(stderr, "kernel_launch: launch failed: %s\n", hipGetErrorName(le));
}
```
